# Optimizing an MI355X kernel written in HIP

```python
import math
import jax, jax.numpy as jnp
from jax import lax
import numpy as np

D_MODEL = 2048
BATCH = 2
SEQ = 16384
DEPTH = 2

GRID_W = 64
CTX_LEN = 256
MIX_WIDTH = D_MODEL
HY_CH = MIX_WIDTH // 2
HY_SHORT = 3
FILTER_EMB = 33
FILTER_BANDS = (FILTER_EMB - 1) // 2
FILTER_HIDDEN = 64
FILTER_DECAY_TARGET = 1e-2
FILTER_SHORT_PCT = 0.3
FILTER_LONG_PCT = 1.5
RET_WIDTH = MIX_WIDTH // 2
RET_HEADS = 8
RET_HEAD_DIM = RET_WIDTH // RET_HEADS
RET_CHUNK = 128
RET_GN_EPS = 1e-5
ROPE_BASE = 10000.0
EVEN_IN = 3 * HY_CH + 4 * RET_WIDTH
RWKV_WIDTH = MIX_WIDTH // 2
RWKV_HEAD_DIM = 64
RWKV_HEADS = RWKV_WIDTH // RWKV_HEAD_DIM
RWKV_DECAY_LORA = 64
RWKV_A_LORA = 64
RWKV_GATE_LORA = 160
RWKV_GN_EPS = 64e-5
RWKV_SHIFT_COLS = 3 * RWKV_WIDTH + RWKV_DECAY_LORA + RWKV_A_LORA + RWKV_GATE_LORA
LRU_WIDTH = MIX_WIDTH // 2
LRU_BLOCKS = 16
LRU_BLOCK_DIM = LRU_WIDTH // LRU_BLOCKS
LRU_CONV = 4
LRU_C = 8.0
ODD_IN = RWKV_SHIFT_COLS + 2 * LRU_WIDTH
PEER_KEYS = 128
PEER_EXPERTS = PEER_KEYS * PEER_KEYS
PEER_HEADS = 8
PEER_QDIM = 256
PEER_TOPK = 16
PEER_BLOCK = 128
N_EVEN = (DEPTH + 1) // 2
N_ODD = DEPTH // 2
DEEPNORM_ALPHA = (2 * DEPTH) ** 0.25
DEEPNORM_BETA = (8 * DEPTH) ** -0.25
LN_EPS = 1e-5

kernel_name = 'hybrid_hyena_retnet_rwkv7_rglru_peer_dit'


def layer_norm(v, g, b):
    vf = v.astype(jnp.float32)
    mu = jnp.mean(vf, -1, keepdims=True)
    var = jnp.mean(jnp.square(vf - mu), -1, keepdims=True)
    return ((vf - mu) * lax.rsqrt(var + LN_EPS) * g + b).astype(g.dtype)


def head_norm(y, eps):
    mu = jnp.mean(y, -1, keepdims=True)
    var = jnp.mean(jnp.square(y - mu), -1, keepdims=True)
    return (y - mu) * lax.rsqrt(var + eps)


def dwconv(u, w, b):
    K, L = w.shape[0], u.shape[1]
    left = (K - 1) // 2
    up = jnp.pad(u, ((0, 0), (left, K - 1 - left), (0, 0)))
    return sum(up[:, k:k + L] * w[k] for k in range(K)) + b


def to_heads(t, n_heads):
    B_, L, W = t.shape
    return t.reshape(B_, L, n_heads, W // n_heads).transpose(0, 2, 1, 3).astype(jnp.float32)


def from_heads(t):
    B_, H, L, dh = t.shape
    return t.transpose(0, 2, 1, 3).reshape(B_, L, H * dh)


def hyena_filter_fft(L, w1, b1, w2, b2, w3, b3, w4, b4, freq):
    pos = jnp.arange(L, dtype=jnp.float32)
    t = pos / max(L - 1, 1)
    bands = jnp.linspace(1e-4, FILTER_BANDS - 1, FILTER_BANDS, dtype=jnp.float32)
    ang = (2.0 * math.pi / L) * pos[:, None] * bands[None, :]
    emb = jnp.concatenate([t[:, None], jnp.cos(ang), -jnp.sin(ang)], -1)
    h = jnp.sin(freq * (emb @ w1 + b1))
    h = jnp.sin(freq * (h @ w2 + b2))
    h = jnp.sin(freq * (h @ w3 + b3))
    h = (h @ w4 + b4).astype(jnp.float32).reshape(L, 2, HY_CH)
    max_decay = math.log(FILTER_DECAY_TARGET) / FILTER_SHORT_PCT
    min_decay = math.log(FILTER_DECAY_TARGET) / FILTER_LONG_PCT
    deltas = jnp.abs(jnp.linspace(min_decay, max_decay, HY_CH, dtype=jnp.float32))
    h = h * jnp.exp(-t[:, None] * deltas[None, :])[:, None, :]
    buf = jnp.concatenate([h[:, 0], jnp.zeros((1, HY_CH), jnp.float32), h[:0:-1, 1]], 0)
    return jnp.fft.rfft(buf, axis=0)


def hyena(p, short_w, short_b, filt_fft, bias):
    L = p.shape[1]
    uc = dwconv(p, short_w, short_b)
    x0, x1, v = jnp.split(uc, 3, axis=-1)
    z = (x1 * v).astype(jnp.float32)
    zf = jnp.fft.rfft(z, n=2 * L, axis=1)
    conv = jnp.fft.irfft(zf * filt_fft[None], n=2 * L, axis=1)[:, :L]
    return (x0 * (conv + z * bias)).astype(p.dtype)


def retention_log_gammas():
    lg = jnp.log1p(-(2.0 ** (-5.0 - jnp.arange(RET_HEADS, dtype=jnp.float32))))
    return lg, lg[::-1]


def axial_rope_tables(rows, cols):
    n_freq = RET_HEAD_DIM // 4
    freqs = ROPE_BASE ** (-jnp.arange(n_freq, dtype=jnp.float32) / n_freq)
    ang = jnp.concatenate([rows[:, None] * freqs, cols[:, None] * freqs], -1)
    return jnp.cos(ang), jnp.sin(ang)


def apply_rope(t, cos, sin):
    t1, t2 = jnp.split(t, 2, axis=-1)
    return jnp.concatenate([t1 * cos - t2 * sin, t1 * sin + t2 * cos], -1)


def retention_qkvg(p, cos, sin):
    q, k, v, g = jnp.split(p, 4, axis=-1)
    q = apply_rope(to_heads(q, RET_HEADS), cos, sin)
    k = apply_rope(to_heads(k, RET_HEADS), cos, sin) * RET_HEAD_DIM ** -0.5
    return q, k, to_heads(v, RET_HEADS), g


def retention_chunkwise(q, k, v, log_gamma, s0, strict):
    B_, H, L, dk = k.shape
    dv = v.shape[-1]
    C = RET_CHUNK
    n = L // C
    kc = k.reshape(B_, H, n, C, dk)
    vc = v.reshape(B_, H, n, C, dv)
    j = jnp.arange(C, dtype=jnp.float32)
    lg = log_gamma[:, None]
    k_dec = kc * jnp.exp(lg * (C - 1 - j))[None, :, None, :, None]
    upd = jnp.einsum('bhncd,bhnce->nbhde', k_dec, vc)
    g_chunk = jnp.exp(log_gamma * C)[None, :, None, None]

    def step(s, u):
        return g_chunk * s + u, s

    s_final, s_prev = lax.scan(step, s0, upd)
    if q is None:
        return None, s_final
    qc = q.reshape(B_, H, n, C, dk)
    diff = j[:, None] - j[None, :]
    mask = diff > 0 if strict else diff >= 0
    decay = jnp.where(mask, jnp.exp(log_gamma[:, None, None] * jnp.maximum(diff, 0.0)), 0.0)
    scores = jnp.einsum('bhncd,bhnmd->bhncm', qc, kc) * decay[None, :, None]
    y = jnp.einsum('bhncm,bhnme->bhnce', scores, vc)
    q_dec = qc * jnp.exp(lg * (j + 1.0))[None, :, None, :, None]
    y = y + jnp.einsum('bhncd,nbhde->bhnce', q_dec, s_prev)
    return y.reshape(B_, H, L, dv), s_final


def retention_output(y, g):
    return from_heads(head_norm(y, RET_GN_EPS)) * jax.nn.silu(g.astype(jnp.float32))


def even_mixer(u_ctx, u_lat, w_in, short_w, short_b, f_w1, f_b1, f_w2, f_b2, f_w3, f_b3, f_w4, f_b4,
               f_freq, hy_bias, w_out, need_ctx_out):
    H3 = 3 * HY_CH
    p_lat = u_lat @ w_in
    p_ctx = u_ctx @ w_in
    L_lat, L_ctx = p_lat.shape[1], p_ctx.shape[1]
    filt = (f_w1, f_b1, f_w2, f_b2, f_w3, f_b3, f_w4, f_b4, f_freq)
    hy_lat = hyena(p_lat[..., :H3], short_w, short_b, hyena_filter_fft(L_lat, *filt), hy_bias)
    lg_f, lg_b = retention_log_gammas()
    pos_l = jnp.arange(L_lat)
    cos_l, sin_l = axial_rope_tables((pos_l // GRID_W).astype(jnp.float32), (pos_l % GRID_W).astype(jnp.float32))
    pos_c = jnp.arange(L_ctx)
    cos_c, sin_c = axial_rope_tables((pos_c - L_ctx).astype(jnp.float32), jnp.zeros((L_ctx,), jnp.float32))
    ql, kl, vl, gl = retention_qkvg(p_lat[..., H3:], cos_l, sin_l)
    qc, kc, vc, gc = retention_qkvg(p_ctx[..., H3:], cos_c, sin_c)
    flip = lambda t: t[:, :, ::-1]
    s0 = jnp.zeros((u_lat.shape[0], RET_HEADS, RET_HEAD_DIM, RET_HEAD_DIM), jnp.float32)
    yc_f, sc_f = retention_chunkwise(qc if need_ctx_out else None, kc, vc, lg_f, s0, False)
    yc_b, sc_b = retention_chunkwise(flip(qc) if need_ctx_out else None, flip(kc), flip(vc), lg_b, s0, True)
    yl_f, _ = retention_chunkwise(ql, kl, vl, lg_f, sc_f, False)
    yl_b, _ = retention_chunkwise(flip(ql), flip(kl), flip(vl), lg_b, sc_b, True)
    ret_lat = retention_output(yl_f + flip(yl_b), gl)
    y_lat = jnp.concatenate([hy_lat.astype(jnp.float32), ret_lat], -1).astype(u_lat.dtype) @ w_out
    y_ctx = None
    if need_ctx_out:
        hy_ctx = hyena(p_ctx[..., :H3], short_w, short_b, hyena_filter_fft(L_ctx, *filt), hy_bias)
        ret_ctx = retention_output(yc_f + flip(yc_b), gc)
        y_ctx = jnp.concatenate([hy_ctx.astype(jnp.float32), ret_ctx], -1).astype(u_ctx.dtype) @ w_out
    return y_ctx, y_lat


def qshift_grid(u, grid_rows):
    B_, L, C = u.shape
    g = u.reshape(B_, grid_rows, GRID_W, C // 4, 4)
    left = jnp.pad(g[:, :, :-1, :, 0], ((0, 0), (0, 0), (1, 0), (0, 0)))
    right = jnp.pad(g[:, :, 1:, :, 1], ((0, 0), (0, 0), (0, 1), (0, 0)))
    up = jnp.pad(g[:, :-1, :, :, 2], ((0, 0), (1, 0), (0, 0), (0, 0)))
    down = jnp.pad(g[:, 1:, :, :, 3], ((0, 0), (0, 1), (0, 0), (0, 0)))
    return jnp.stack([left, right, up, down], -1).reshape(B_, L, C)


def bishift_seq(u):
    B_, L, C = u.shape
    g = u.reshape(B_, L, C // 2, 2)
    prev = jnp.pad(g[:, :-1, :, 0], ((0, 0), (1, 0), (0, 0)))
    nxt = jnp.pad(g[:, 1:, :, 1], ((0, 0), (0, 1), (0, 0)))
    return jnp.stack([prev, nxt], -1).reshape(B_, L, C)


def rwkv_features(rw, w0, w2, a0, a2, k_k, k_a):
    B_, L, _ = rw.shape
    W, DL, AL = RWKV_WIDTH, RWKV_DECAY_LORA, RWKV_A_LORA
    rw = rw.astype(jnp.float32)
    heads = lambda t: t.reshape(B_, L, RWKV_HEADS, RWKV_HEAD_DIM)
    r, k, v = rw[..., :W], rw[..., W:2 * W], rw[..., 2 * W:3 * W]
    wl = rw[..., 3 * W:3 * W + DL]
    al = rw[..., 3 * W + DL:3 * W + DL + AL]
    gl = rw[..., 3 * W + DL + AL:]
    kk = heads(k * k_k)
    kk = kk / jnp.maximum(jnp.sqrt(jnp.sum(kk * kk, -1, keepdims=True)), 1e-12)
    dirs = []
    for d in range(2):
        w_log = -jax.nn.softplus(-(w0[d] + jnp.tanh(wl) @ w2[d])) - 0.5
        a = jax.nn.sigmoid(a0[d] + al @ a2[d])
        k_d = k * (1.0 + (a - 1.0) * k_a)
        dirs.append((heads(jnp.exp(-jnp.exp(w_log))), heads(k_d), heads(a)))
    return heads(r), heads(v), kk, gl, dirs


def rwkv7_scan(r, w, k, v, kk, a, s0):
    need_out = r is not None

    def step(s, inp):
        w_t, k_t, v_t, kk_t, a_t = inp[:5]
        sa = jnp.einsum('bhvk,bhk->bhv', s, kk_t)
        s = s * w_t[:, :, None, :] - sa[..., None] * (kk_t * a_t)[:, :, None, :] + v_t[..., None] * k_t[:, :, None, :]
        y = jnp.einsum('bhvk,bhk->bhv', s, inp[5]) if need_out else None
        return s, y

    seq = (w, k, v, kk, a) + ((r,) if need_out else ())
    s_final, ys = lax.scan(step, s0, tuple(jnp.moveaxis(t, 1, 0) for t in seq))
    return (jnp.moveaxis(ys, 0, 1) if need_out else None), s_final


def rwkv_output(y, r, v, keys_dir, gl, r_k, gn_g, gn_b, g2):
    B_, L = y.shape[:2]
    yn = head_norm(y, RWKV_GN_EPS).reshape(B_, L, RWKV_WIDTH) * gn_g + gn_b
    bonus = sum(jnp.sum(r * kd * r_k, -1, keepdims=True) * v for kd in keys_dir).reshape(B_, L, RWKV_WIDTH)
    return (yn + bonus) * (jax.nn.sigmoid(gl) @ g2)


def rglru_coeffs(xc, wa, ba, wx, bx, lam):
    B_, L, W = xc.shape
    xb = xc.reshape(B_, L, LRU_BLOCKS, LRU_BLOCK_DIM)
    r = jax.nn.sigmoid(jnp.einsum('blhi,hij->blhj', xb, wa).reshape(B_, L, W) + ba)
    i = jax.nn.sigmoid(jnp.einsum('blhi,hij->blhj', xb, wx).reshape(B_, L, W) + bx)
    log_a = -LRU_C * r * jax.nn.softplus(-lam)
    return jnp.exp(log_a), jnp.sqrt(-jnp.expm1(2.0 * log_a)) * (i * xc)


def linear_scan(a, b, h0):
    A, Bc = lax.associative_scan(lambda e1, e2: (e1[0] * e2[0], e2[0] * e1[1] + e2[1]), (a, b), axis=1)
    return Bc + A * h0[:, None]


def odd_mixer(u_ctx, u_lat, grid_rows, w_in, mu, w0, w2, a0, a2, g2, k_k, k_a, r_k, gn_g, gn_b,
              conv_w, conv_b, lru_wa, lru_ba, lru_wx, lru_bx, lru_lam, w_out, need_ctx_out):
    R, WL = RWKV_SHIFT_COLS, LRU_WIDTH
    B_ = u_lat.shape[0]
    p_lat = u_lat @ w_in
    p_ctx = u_ctx @ w_in
    sl = p_lat[..., :R]
    sl = sl + (qshift_grid(sl, grid_rows) - sl) * mu
    sc = p_ctx[..., :R]
    sc = sc + (bishift_seq(sc) - sc) * mu
    rl, vl, kkl, gll, dirs_l = rwkv_features(sl, w0, w2, a0, a2, k_k, k_a)
    rc, vc, kkc, glc, dirs_c = rwkv_features(sc, w0, w2, a0, a2, k_k, k_a)
    s0 = jnp.zeros((B_, RWKV_HEADS, RWKV_HEAD_DIM, RWKV_HEAD_DIM), jnp.float32)
    xl = dwconv(p_lat[..., R:R + WL], conv_w, conv_b).astype(jnp.float32)
    xc = dwconv(p_ctx[..., R:R + WL], conv_w, conv_b).astype(jnp.float32)
    h0 = jnp.zeros((B_, WL), jnp.float32)
    y_rw_l, y_lru_l, y_rw_c, y_lru_c = 0.0, 0.0, 0.0, 0.0
    for d in range(2):
        f = (lambda t: t) if d == 0 else (lambda t: t[:, ::-1])
        wc, kc, ac = dirs_c[d]
        yc, s_ctx = rwkv7_scan(f(rc) if need_ctx_out else None, f(wc), f(kc), f(vc), f(kkc), f(ac), s0)
        wl_, kl_, al_ = dirs_l[d]
        yl, _ = rwkv7_scan(f(rl), f(wl_), f(kl_), f(vl), f(kkl), f(al_), s_ctx)
        y_rw_l = y_rw_l + f(yl)
        ca, cb = rglru_coeffs(xc, lru_wa[d], lru_ba[d], lru_wx[d], lru_bx[d], lru_lam[d])
        hc = linear_scan(f(ca), f(cb), h0)
        la, lb = rglru_coeffs(xl, lru_wa[d], lru_ba[d], lru_wx[d], lru_bx[d], lru_lam[d])
        hl = linear_scan(f(la), f(lb), hc[:, -1])
        y_lru_l = y_lru_l + f(hl)
        if need_ctx_out:
            y_rw_c = y_rw_c + f(yc)
            y_lru_c = y_lru_c + f(hc)

    def merge(y_rw, y_lru, r, v, dirs, gl, p, dtype):
        rw = rwkv_output(y_rw, r, v, [dd[1] for dd in dirs], gl, r_k, gn_g, gn_b, g2)
        lru = y_lru * jax.nn.gelu(p[..., R + WL:].astype(jnp.float32))
        return jnp.concatenate([rw, lru], -1).astype(dtype) @ w_out

    y_lat = merge(y_rw_l, y_lru_l, rl, vl, dirs_l, gll, p_lat, u_lat.dtype)
    y_ctx = merge(y_rw_c, y_lru_c, rc, vc, dirs_c, glc, p_ctx, u_ctx.dtype) if need_ctx_out else None
    return y_ctx, y_lat


def peer(u, wq, keys, u_tab, v_tab):
    B_, L, D = u.shape
    xt = u.reshape(-1, PEER_BLOCK, D)

    def block(xb):
        q = (xb @ wq).reshape(PEER_BLOCK, PEER_HEADS, 2, PEER_QDIM // 2)
        s = jnp.einsum('thpk,hpnk->thpn', q, keys).astype(jnp.float32)
        s1, i1 = lax.top_k(s[:, :, 0], PEER_TOPK)
        s2, i2 = lax.top_k(s[:, :, 1], PEER_TOPK)
        cand = (s1[..., :, None] + s2[..., None, :]).reshape(PEER_BLOCK, PEER_HEADS, PEER_TOPK * PEER_TOPK)
        cidx = (i1[..., :, None] * PEER_KEYS + i2[..., None, :]).reshape(PEER_BLOCK, PEER_HEADS, PEER_TOPK * PEER_TOPK)
        top_s, pos = lax.top_k(cand, PEER_TOPK)
        idx = jnp.take_along_axis(cidx, pos, axis=-1)
        gate = jax.nn.softmax(top_s, axis=-1)
        h = jnp.einsum('td,thkd->thk', xb, u_tab[idx])
        act = (jax.nn.gelu(h.astype(jnp.float32)) * gate).astype(xb.dtype)
        return jnp.einsum('thk,thkd->td', act, v_tab[idx])

    return lax.map(block, xt).reshape(B_, L, D)


def setup_inputs(seed: int = 0) -> dict:
    key = jax.random.key(seed)
    ks = iter(jax.random.split(key, 64))
    nrm = lambda shape, scale: jax.random.normal(next(ks), shape, jnp.float32) * scale
    uni = lambda shape, lo, hi: jax.random.uniform(next(ks), shape, jnp.float32, lo, hi)
    D = D_MODEL
    inp = {}
    inp['x'] = nrm((BATCH, SEQ, D), 1.0)
    inp['c'] = nrm((BATCH, D), 1.0)
    inp['ctx'] = nrm((BATCH, CTX_LEN, D), 1.0)
    inp['c_ctx'] = nrm((D,), 1.0)
    inp['ada_w'] = nrm((DEPTH, D, 6 * D), 0.5 * D ** -0.5)
    inp['ada_b'] = nrm((DEPTH, 6 * D), 0.01)
    inp['ln_g'] = 1.0 + nrm((DEPTH, 2, D), 0.01)
    inp['ln_b'] = nrm((DEPTH, 2, D), 0.01)
    inp['ev_w_in'] = nrm((N_EVEN, D, EVEN_IN), D ** -0.5)
    inp['hy_short_w'] = nrm((N_EVEN, HY_SHORT, 3 * HY_CH), HY_SHORT ** -0.5)
    inp['hy_short_b'] = nrm((N_EVEN, 3 * HY_CH), 0.01)
    inp['hy_f_w1'] = nrm((N_EVEN, FILTER_EMB, FILTER_HIDDEN), FILTER_EMB ** -0.5)
    inp['hy_f_b1'] = nrm((N_EVEN, FILTER_HIDDEN), 0.1)
    inp['hy_f_w2'] = nrm((N_EVEN, FILTER_HIDDEN, FILTER_HIDDEN), FILTER_HIDDEN ** -0.5)
    inp['hy_f_b2'] = nrm((N_EVEN, FILTER_HIDDEN), 0.1)
    inp['hy_f_w3'] = nrm((N_EVEN, FILTER_HIDDEN, FILTER_HIDDEN), FILTER_HIDDEN ** -0.5)
    inp['hy_f_b3'] = nrm((N_EVEN, FILTER_HIDDEN), 0.1)
    inp['hy_f_w4'] = nrm((N_EVEN, FILTER_HIDDEN, 2 * HY_CH), 0.01)
    inp['hy_f_b4'] = nrm((N_EVEN, 2 * HY_CH), 0.01)
    inp['hy_f_freq'] = 1.0 + nrm((N_EVEN, FILTER_HIDDEN), 0.01)
    inp['hy_bias'] = nrm((N_EVEN, HY_CH), 0.5)
    inp['ev_w_out'] = nrm((N_EVEN, MIX_WIDTH, D), DEEPNORM_BETA * MIX_WIDTH ** -0.5)
    inp['od_w_in'] = nrm((N_ODD, D, ODD_IN), D ** -0.5)
    inp['rw_mu'] = uni((N_ODD, RWKV_SHIFT_COLS), 0.0, 1.0)
    inp['rw_w0'] = uni((N_ODD, 2, RWKV_WIDTH), -6.0, -1.0)
    inp['rw_w2'] = nrm((N_ODD, 2, RWKV_DECAY_LORA, RWKV_WIDTH), 0.1 * RWKV_DECAY_LORA ** -0.5)
    inp['rw_a0'] = nrm((N_ODD, 2, RWKV_WIDTH), 0.1)
    inp['rw_a2'] = nrm((N_ODD, 2, RWKV_A_LORA, RWKV_WIDTH), RWKV_A_LORA ** -0.5)
    inp['rw_g2'] = nrm((N_ODD, RWKV_GATE_LORA, RWKV_WIDTH), RWKV_GATE_LORA ** -0.5)
    inp['rw_k_k'] = 0.85 + nrm((N_ODD, RWKV_WIDTH), 0.02)
    inp['rw_k_a'] = 1.0 + nrm((N_ODD, RWKV_WIDTH), 0.02)
    inp['rw_r_k'] = nrm((N_ODD, RWKV_HEADS, RWKV_HEAD_DIM), 0.1)
    inp['rw_gn_g'] = 1.0 + nrm((N_ODD, RWKV_WIDTH), 0.01)
    inp['rw_gn_b'] = nrm((N_ODD, RWKV_WIDTH), 0.01)
    inp['lru_conv_w'] = nrm((N_ODD, LRU_CONV, LRU_WIDTH), LRU_CONV ** -0.5)
    inp['lru_conv_b'] = nrm((N_ODD, LRU_WIDTH), 0.01)
    inp['lru_wa'] = nrm((N_ODD, 2, LRU_BLOCKS, LRU_BLOCK_DIM, LRU_BLOCK_DIM), LRU_BLOCK_DIM ** -0.5)
    inp['lru_ba'] = nrm((N_ODD, 2, LRU_WIDTH), 0.01)
    inp['lru_wx'] = nrm((N_ODD, 2, LRU_BLOCKS, LRU_BLOCK_DIM, LRU_BLOCK_DIM), LRU_BLOCK_DIM ** -0.5)
    inp['lru_bx'] = nrm((N_ODD, 2, LRU_WIDTH), 0.01)
    a_pow = uni((N_ODD, 2, LRU_WIDTH), 0.9, 0.999) ** (1.0 / LRU_C)
    inp['lru_lam'] = jnp.log(a_pow) - jnp.log1p(-a_pow)
    inp['od_w_out'] = nrm((N_ODD, MIX_WIDTH, D), DEEPNORM_BETA * MIX_WIDTH ** -0.5)
    inp['peer_wq'] = nrm((DEPTH, D, PEER_HEADS * PEER_QDIM), D ** -0.5)
    inp['peer_keys'] = nrm((DEPTH, PEER_HEADS, 2, PEER_KEYS, PEER_QDIM // 2), (PEER_QDIM // 2) ** -0.5)
    inp['peer_u'] = nrm((DEPTH, PEER_EXPERTS, D), D ** -0.5)
    inp['peer_v'] = nrm((DEPTH, PEER_EXPERTS, D), DEEPNORM_BETA)
    return inp


def reference(x, c, ctx, c_ctx, ada_w, ada_b, ln_g, ln_b,
              ev_w_in, hy_short_w, hy_short_b, hy_f_w1, hy_f_b1, hy_f_w2, hy_f_b2, hy_f_w3, hy_f_b3,
              hy_f_w4, hy_f_b4, hy_f_freq, hy_bias, ev_w_out,
              od_w_in, rw_mu, rw_w0, rw_w2, rw_a0, rw_a2, rw_g2, rw_k_k, rw_k_a, rw_r_k, rw_gn_g, rw_gn_b,
              lru_conv_w, lru_conv_b, lru_wa, lru_ba, lru_wx, lru_bx, lru_lam, od_w_out,
              peer_wq, peer_keys, peer_u, peer_v):
    grid_rows = x.shape[1] // GRID_W
    x_lat, x_ctx = x, ctx
    for l in range(DEPTH):
        need_ctx_out = l < DEPTH - 1
        i = l // 2
        mod_lat = (jax.nn.silu(c) @ ada_w[l] + ada_b[l])[:, None, :]
        mod_ctx = (jax.nn.silu(c_ctx) @ ada_w[l] + ada_b[l])[None, None, :]
        sh1, sc1, gt1, sh2, sc2, gt2 = jnp.split(mod_lat, 6, axis=-1)
        csh1, csc1, cgt1, csh2, csc2, cgt2 = jnp.split(mod_ctx, 6, axis=-1)
        u_lat = x_lat * (1.0 + sc1) + sh1
        u_ctx = x_ctx * (1.0 + csc1) + csh1
        if l % 2 == 0:
            y_ctx, y_lat = even_mixer(u_ctx, u_lat, ev_w_in[i], hy_short_w[i], hy_short_b[i],
                                      hy_f_w1[i], hy_f_b1[i], hy_f_w2[i], hy_f_b2[i], hy_f_w3[i], hy_f_b3[i],
                                      hy_f_w4[i], hy_f_b4[i], hy_f_freq[i], hy_bias[i], ev_w_out[i], need_ctx_out)
        else:
            y_ctx, y_lat = odd_mixer(u_ctx, u_lat, grid_rows, od_w_in[i], rw_mu[i], rw_w0[i], rw_w2[i],
                                     rw_a0[i], rw_a2[i], rw_g2[i], rw_k_k[i], rw_k_a[i], rw_r_k[i],
                                     rw_gn_g[i], rw_gn_b[i], lru_conv_w[i], lru_conv_b[i], lru_wa[i], lru_ba[i],
                                     lru_wx[i], lru_bx[i], lru_lam[i], od_w_out[i], need_ctx_out)
        x_lat = layer_norm(DEEPNORM_ALPHA * x_lat + gt1 * y_lat, ln_g[l, 0], ln_b[l, 0])
        ffn_lat = peer(x_lat * (1.0 + sc2) + sh2, peer_wq[l], peer_keys[l], peer_u[l], peer_v[l])
        x_lat = layer_norm(DEEPNORM_ALPHA * x_lat + gt2 * ffn_lat, ln_g[l, 1], ln_b[l, 1])
        if need_ctx_out:
            x_ctx = layer_norm(DEEPNORM_ALPHA * x_ctx + cgt1 * y_ctx, ln_g[l, 0], ln_b[l, 0])
            ffn_ctx = peer(x_ctx * (1.0 + csc2) + csh2, peer_wq[l], peer_keys[l], peer_u[l], peer_v[l])
            x_ctx = layer_norm(DEEPNORM_ALPHA * x_ctx + cgt2 * ffn_ctx, ln_g[l, 1], ln_b[l, 1])
    return x_lat
```

```cpp
#ifndef EMU
#include <hip/hip_runtime.h>
#endif
#include <stdint.h>
#include <stddef.h>

#ifndef D_MODEL
#define D_MODEL 2048
#endif
#ifndef BATCH
#define BATCH 2
#endif
#ifndef SEQ
#define SEQ 16384
#endif
#ifndef GRID_W
#define GRID_W 64
#endif
#ifndef CTX_LEN
#define CTX_LEN 256
#endif
#ifndef PEER_KEYS
#define PEER_KEYS 128
#endif
#ifndef RET_HEADS
#define RET_HEADS 8
#endif
#ifndef LRU_BLOCKS
#define LRU_BLOCKS 16
#endif

typedef _Float16 h16;
typedef h16 h16x8 __attribute__((ext_vector_type(8)));
typedef h16 h16x4 __attribute__((ext_vector_type(4)));
typedef h16 h16x2 __attribute__((ext_vector_type(2)));
typedef float f32x4 __attribute__((ext_vector_type(4)));
typedef unsigned u32x2 __attribute__((ext_vector_type(2)));
typedef unsigned u32x4 __attribute__((ext_vector_type(4)));

constexpr int NTHR = 512;
#define DPT ((D_MODEL + 511) / 512)
constexpr int D = D_MODEL;
constexpr int D6 = 6 * D;
constexpr int HY_CH = D / 2;
constexpr int RETW = D / 2;
constexpr int RET_HD = RETW / RET_HEADS;
constexpr int RET_C = 128;
constexpr int EVEN_IN = 3 * HY_CH + 4 * RETW;
constexpr int RWW = D / 2;
constexpr int RW_HD = 64;
constexpr int RW_H = RWW / RW_HD;
constexpr int RW_SHIFT = 3 * RWW + 64 + 64 + 160;
constexpr int LRUW = D / 2;
constexpr int LRU_BD = LRUW / LRU_BLOCKS;
constexpr int ODD_IN = RW_SHIFT + 2 * LRUW;
constexpr int PEER_E = PEER_KEYS * PEER_KEYS;
constexpr int PEER_H = 8;
constexpr int PEER_QD = 256;
constexpr int QW = PEER_H * PEER_QD;
constexpr int TOPK = 16;
constexpr int NSEL = PEER_H * TOPK;
constexpr int NL = BATCH * SEQ;
constexpr int NC = BATCH * CTX_LEN;
constexpr int NT = NL + NC;
constexpr int GRID_ROWS = SEQ / GRID_W;
constexpr int FH = 64;
constexpr int FE = 33;
constexpr int ru256(int x) { return (x + 255) / 256 * 256; }
constexpr int NP_EV = ru256(EVEN_IN);
constexpr int NP_OD = ru256(ODD_IN);
constexpr float ALPHA = 1.41421356237309515f;
constexpr float LN_EPS = 1e-5f;
constexpr float RET_EPS = 1e-5f;
constexpr float RW_EPS = 64e-5f;
constexpr int LRU_T = 64;
constexpr int LRU_LCH = SEQ / LRU_T, LRU_CCH = CTX_LEN / LRU_T, LRU_NCH = LRU_LCH + LRU_CCH;
constexpr int RET_LCH = SEQ / RET_C, RET_CCH = CTX_LEN / RET_C, RET_NCH = RET_LCH + RET_CCH;
static_assert(RET_HD == 128, "retention head dim");
static_assert(LRU_BD == 64, "lru block dim");
static_assert(NT % 256 == 0 && NL % 256 == 0, "rows");
static_assert(D % 128 == 0 && D >= 256, "K");

constexpr size_t LDS_BYTES = 131072 + 1024;

constexpr size_t al256(size_t x) { return (x + 255) / 256 * 256; }
constexpr size_t cmax(size_t a, size_t b) { return a > b ? a : b; }
#ifdef EMU
constexpr int MAXGRID = 8;
#else
constexpr int MAXGRID = 256;
#endif
constexpr size_t O_BAR = 0;
constexpr size_t O_MOD = 16384;
constexpr size_t O_ROPE = O_MOD + al256((size_t)2 * 3 * D6 * 4);
constexpr size_t O_TW = O_ROPE + al256((size_t)2 * (SEQ + CTX_LEN) * 64 * 4);
constexpr size_t O_XC1 = O_TW + al256((size_t)SEQ * 4);
constexpr size_t O_XC2 = O_XC1 + al256((size_t)NC * D * 4);
constexpr size_t O_WIN = O_XC2 + al256((size_t)NC * D * 4);
constexpr size_t O_WOUT = O_WIN + al256((size_t)cmax(NP_EV, NP_OD) * D * 2);
constexpr size_t O_WQ = O_WOUT + al256((size_t)D * D * 2);
constexpr size_t O_TABU = O_WQ + al256((size_t)QW * D * 2);
constexpr size_t O_TABV = O_TABU + al256((size_t)PEER_E * D * 2);
constexpr size_t O_KEYS16 = O_TABV + al256((size_t)PEER_E * D * 2);
constexpr size_t O_LW16 = O_KEYS16 + al256((size_t)PEER_H * 2 * PEER_KEYS * 128 * 2);
constexpr size_t O_RW16 = O_LW16 + al256((size_t)2 * LRU_BLOCKS * 2 * 64 * 64 * 2);
constexpr size_t O_G216 = O_RW16 + al256((size_t)2 * 2 * RWW * 64 * 2);
constexpr size_t O_ABUF = O_G216 + al256((size_t)RWW * 160 * 2);
constexpr size_t O_SELI = O_ABUF + al256((size_t)NT * D * 2);
constexpr size_t O_SELG = O_SELI + al256((size_t)NT * NSEL * 4);
constexpr size_t O_ARENA = O_SELG + al256((size_t)NT * NSEL * 4);
constexpr size_t O_P0 = O_ARENA;
constexpr size_t SZ_P0 = cmax((size_t)NT * NP_EV * 2, cmax((size_t)NT * D * 4, (size_t)NT * QW * 4));
constexpr size_t O_H3 = O_P0 + al256(SZ_P0);
constexpr size_t O_FILT = O_H3 + al256((size_t)(SEQ + CTX_LEN) * FH * 4);
constexpr size_t O_FILTC = O_FILT + al256((size_t)HY_CH * 2 * SEQ * 4);
constexpr size_t O_FFTS = O_FILTC + al256((size_t)HY_CH * 2 * CTX_LEN * 4);
constexpr size_t END_L0 = O_FFTS + al256((size_t)MAXGRID * 2 * SEQ * 8);
constexpr size_t O_PRW = O_ARENA;
constexpr size_t O_PLRU = O_PRW + al256((size_t)NT * RW_SHIFT * 2);
constexpr size_t O_FEAT = O_PLRU + al256((size_t)NT * 2 * LRUW * 2);
constexpr size_t O_MIXLRU = O_FEAT + al256(cmax((size_t)5 * NT * RWW * 2, cmax((size_t)NL * D * 4, (size_t)NL * QW * 4)));
constexpr size_t O_GLS = O_MIXLRU + al256((size_t)NL * LRUW * 2);
constexpr size_t O_BONUS = O_GLS + al256((size_t)NT * 160 * 2);
constexpr size_t O_LSUM = O_BONUS + al256((size_t)NT * RW_H * 4);
constexpr size_t O_LCAR = O_LSUM + al256((size_t)2 * BATCH * LRU_NCH * LRUW * 8);
constexpr size_t O_RWST = O_LCAR + al256((size_t)2 * BATCH * LRU_NCH * LRUW * 4);
constexpr size_t END_L1 = O_RWST + 256;
constexpr size_t WS_NEED = cmax(END_L0, END_L1);

#define PARAM_FIELDS(X) \
  X(x) X(c) X(ctx) X(c_ctx) X(ada_w) X(ada_b) X(ln_g) X(ln_b) \
  X(ev_w_in) X(hy_short_w) X(hy_short_b) X(f_w1) X(f_b1) X(f_w2) X(f_b2) X(f_w3) X(f_b3) X(f_w4) X(f_b4) X(f_freq) X(hy_bias) X(ev_w_out) \
  X(od_w_in) X(rw_mu) X(rw_w0) X(rw_w2) X(rw_a0) X(rw_a2) X(rw_g2) X(rw_k_k) X(rw_k_a) X(rw_r_k) X(rw_gn_g) X(rw_gn_b) \
  X(lru_conv_w) X(lru_conv_b) X(lru_wa) X(lru_ba) X(lru_wx) X(lru_bx) X(lru_lam) X(od_w_out) \
  X(peer_wq) X(peer_keys) X(peer_u) X(peer_v)
struct Params {
#define X(f) const float* f;
  PARAM_FIELDS(X)
#undef X
  float* out;
  char* ws;
};

#ifdef EMU
#define MFMA16(a, b, c) emu_mfma16(a, b, c)
#else
#define MFMA16(a, b, c) __builtin_amdgcn_mfma_f32_16x16x32_f16(a, b, c, 0, 0, 0)
#endif
__device__ __forceinline__ float sigmoidf_(float x) { return 1.0f / (1.0f + expf(-x)); }
__device__ __forceinline__ float siluf_(float x) { return x * sigmoidf_(x); }
__device__ __forceinline__ float softplusf_(float x) { return x > 20.f ? x : log1pf(expf(x)); }
__device__ __forceinline__ float geluf_(float x) { return 0.5f * x * (1.0f + tanhf(0.7978845608028654f * (x + 0.044715f * x * x * x))); }

#ifdef EMU
#define GRID_SYNC() emu_grid_sync()
#define DECL_SMEM char* smem = emu_get_smem()
#else
#define DECL_SMEM extern __shared__ __attribute__((aligned(16))) char smem[]
#endif

#ifdef EMU
#define TIDX ((int)threadIdx.x)
#else
__device__ __forceinline__ int tid_fn() { int t = threadIdx.x; asm volatile("" : "+v"(t)); return t; }
#define TIDX tid_fn()
#endif
__device__ __forceinline__ void block_sum2(float& a, float& b, float* red) {
#ifdef EMU
  __syncthreads();
  if (TIDX == 0) { red[0] = 0; red[1] = 0; }
  __syncthreads();
  for (int i = 0; i < NTHR; ++i) { if ((int)TIDX == i) { red[0] += a; red[1] += b; } }
  __syncthreads();
  a = red[0]; b = red[1];
  __syncthreads();
#else
  for (int m = 32; m >= 1; m >>= 1) { a += __shfl_xor(a, m); b += __shfl_xor(b, m); }
  __syncthreads();
  if ((TIDX & 63) == 0) { red[(TIDX >> 6) * 2] = a; red[(TIDX >> 6) * 2 + 1] = b; }
  __syncthreads();
  a = 0; b = 0;
  for (int w = 0; w < NTHR / 64; ++w) { a += red[w * 2]; b += red[w * 2 + 1]; }
  __syncthreads();
#endif
}

#ifdef EMU
__device__ __forceinline__ float row_sum16(float v) { v += __shfl_xor(v, 1); v += __shfl_xor(v, 2); v += __shfl_xor(v, 4); v += __shfl_xor(v, 8); return v; }
__device__ __forceinline__ float wave_sum(float v) { v = row_sum16(v); v += __shfl_xor(v, 16); v += __shfl_xor(v, 32); return v; }
#else
template <int CTRL> __device__ __forceinline__ float dppf(float v) {
  return __builtin_bit_cast(float, __builtin_amdgcn_update_dpp(0, __builtin_bit_cast(int, v), CTRL, 0xF, 0xF, true));
}
__device__ __forceinline__ float row_sum16(float v) { v += dppf<0xB1>(v); v += dppf<0x4E>(v); v += dppf<0x124>(v); v += dppf<0x128>(v); return v; }
__device__ __forceinline__ float wave_sum(float v) {
  v = row_sum16(v);
  const float r0 = __builtin_bit_cast(float, __builtin_amdgcn_readlane(__builtin_bit_cast(int, v), 0));
  const float r1 = __builtin_bit_cast(float, __builtin_amdgcn_readlane(__builtin_bit_cast(int, v), 16));
  const float r2 = __builtin_bit_cast(float, __builtin_amdgcn_readlane(__builtin_bit_cast(int, v), 32));
  const float r3 = __builtin_bit_cast(float, __builtin_amdgcn_readlane(__builtin_bit_cast(int, v), 48));
  return (r0 + r1) + (r2 + r3);
}
#endif
__device__ __forceinline__ void row_decode(int row, int& isctx, int& b, int& t) {
  if (row < NL) { isctx = 0; b = row / SEQ; t = row % SEQ; }
  else { int r = row - NL; isctx = 1; b = r / CTX_LEN; t = r % CTX_LEN; }
}
__device__ __forceinline__ const float* mod_ptr(const Params& P, int layer, int row, int which) {
  int mr = row < NL ? row / SEQ : BATCH;
  return (const float*)(P.ws + O_MOD) + ((size_t)(layer * 3 + mr) * 6 + which) * D;
}

#ifndef EMU
#define XB_TMO      128
#define XB_XCNT(j)  (256  + 64 * (j))
#define XB_XSUB(j)  (1280 + 64 * (j))
#define XB_XGEN(j)  (2304 + 64 * (j))
#define XB_TOP      3328
#define XB_TOPGEN   3392
#define XCD_BAR_WORDS 3456
#define XB_SPIN_CAP (1u << 22)
#define LAS __attribute__((address_space(3)))
__device__ __forceinline__ unsigned xb_ld(unsigned* p)              { return __hip_atomic_load(p, __ATOMIC_RELAXED, __HIP_MEMORY_SCOPE_AGENT); }
__device__ __forceinline__ unsigned xb_add(unsigned* p, unsigned v) { return __hip_atomic_fetch_add(p, v, __ATOMIC_RELAXED, __HIP_MEMORY_SCOPE_AGENT); }
__device__ __forceinline__ unsigned xb_xcc_id() { return (unsigned)__builtin_amdgcn_s_getreg((3 << 11) | 20) & 0xFu; }
#define XB_SPIN(cond, bar) do { unsigned _sp = 0; while (cond) { __builtin_amdgcn_s_sleep(1); \
    if ((++_sp & 255u) == 0u) { if (xb_ld(&(bar)[XB_TMO])) break; if (_sp > XB_SPIN_CAP) { atomicAdd(&(bar)[XB_TMO], 1u); break; } } } } while (0)
struct XcdBarrier { unsigned* bar; unsigned x; volatile LAS unsigned* st; };
__device__ __forceinline__ XcdBarrier xcd_barrier_post(unsigned* bar, volatile LAS unsigned* st) {
    XcdBarrier b; b.bar = bar; b.x = xb_xcc_id(); b.st = st;
    if (threadIdx.x == 0) (void)xb_add(&bar[XB_XCNT(b.x)], 1u);
    return b;
}
__device__ __forceinline__ void xcd_barrier_complete(unsigned* bar, unsigned x, unsigned& nloc, unsigned& nx) {
    const unsigned G = gridDim.x * gridDim.y * gridDim.z;
    unsigned sum, cnt, mine, sp = 0u;
    for (;;) {
        sum = 0u; cnt = 0u; mine = 0u;
#pragma unroll
        for (unsigned j = 0; j < 16; ++j) { const unsigned c = xb_ld(&bar[XB_XCNT(j)]); sum += c; cnt += (c > 0u) ? 1u : 0u; mine = (j == x) ? c : mine; }
        if (sum == G) break;
        __builtin_amdgcn_s_sleep(1);
        if ((++sp & 255u) == 0u) { if (xb_ld(&bar[XB_TMO])) break; if (sp > XB_SPIN_CAP) { atomicAdd(&bar[XB_TMO], 1u); break; } }
    }
    nloc = mine > 0u ? mine : 1u; nx = cnt > 0u ? cnt : 1u;
}
__device__ __forceinline__ void xcd_barrier(const XcdBarrier& b) {
    asm volatile("s_waitcnt vmcnt(0)" ::: "memory");
    __syncthreads();
    if (threadIdx.x == 0) {
        unsigned* bar = b.bar;
        __builtin_amdgcn_s_waitcnt(0);
        unsigned nloc = b.st[0], nx = b.st[1];
        if (nloc == 0u) { xcd_barrier_complete(bar, b.x, nloc, nx); b.st[0] = nloc; b.st[1] = nx; }
        const unsigned old = xb_add(&bar[XB_XSUB(b.x)], 1u);
        const unsigned gen = old / nloc;
        if (old + 1u == (gen + 1u) * nloc) {
            __builtin_amdgcn_fence(__ATOMIC_RELEASE, "agent");
            asm volatile("s_waitcnt vmcnt(0)" ::: "memory");
            const unsigned og = xb_add(&bar[XB_TOP], 1u);
            const unsigned tg = og / nx;
            if (og + 1u == (tg + 1u) * nx) xb_add(&bar[XB_TOPGEN], 1u);
            else XB_SPIN(xb_ld(&bar[XB_TOPGEN]) == tg, bar);
            __builtin_amdgcn_fence(__ATOMIC_ACQUIRE, "agent");
            xb_add(&bar[XB_XGEN(b.x)], 1u);
            asm volatile("s_waitcnt vmcnt(0)" ::: "memory");
        } else {
            XB_SPIN(xb_ld(&bar[XB_XGEN(b.x)]) == gen, bar);
            __builtin_amdgcn_fence(__ATOMIC_ACQUIRE, "agent");
            asm volatile("s_waitcnt vmcnt(0)" ::: "memory");
        }
    }
    __syncthreads();
}
#define GRID_SYNC() xcd_barrier(gbar)
#endif

#ifndef EMU
constexpr int G_BK = 64, G_HALF = 128, G_HT = G_HALF * G_BK;
__device__ __forceinline__ int g_lds_byte(int r, int c) {
  int st = (r >> 4) * 2 + (c >> 5), rr = r & 15, cc = c & 31, ob = rr * 64 + cc * 2;
  return st * 1024 + (ob ^ (((ob >> 9) & 1) << 5));
}
__device__ __forceinline__ void g_stage_rc(int b, int& R, int& C) {
  int st = b / 1024, sb = b % 1024, swz = sb ^ (((sb >> 9) & 1) << 5);
  R = (st >> 1) * 16 + swz / 64; C = (st & 1) * 32 + (swz % 64) / 2;
}
#else
template <bool SPLIT, int lda0, int lda1, int ksp, class Epi>
__device__ __forceinline__ void gemm_tile(const h16* A0, const h16* A1,
                          const h16* Bt, int brow, int bcol, char* smem, const Epi& epi) {
  constexpr int K = D;
  for (int o = TIDX; o < 256 * 64; o += NTHR) {
    int r = brow + o / 64, c0 = bcol + (o % 64) * 4;
    f32x4 acc = (f32x4){0.f, 0.f, 0.f, 0.f};
    for (int k = 0; k < K; ++k) {
      int kt = k / 64;
      float a = (!SPLIT || kt < ksp) ? (float)A0[(size_t)r * lda0 + k] : (float)A1[(size_t)r * lda1 + (k - ksp * 64)];
      for (int q = 0; q < 4; ++q) acc[q] += a * (float)Bt[(size_t)(c0 + q) * K + k];
    }
    epi(r, c0, acc);
  }
}
#endif

__device__ __forceinline__ void gemm_tile_coords(int tile, int nM, int nN, int& pm, int& pn) {
  const int band = tile / (8 * nN), rem = tile % (8 * nN);
  const int bm0 = band * 8, bsz = (nM - bm0) < 8 ? (nM - bm0) : 8;
  if (bsz == 8) { pm = bm0 + rem % 8; pn = rem / 8; } else { pm = bm0 + rem % bsz; pn = rem / bsz; }
}
#ifdef EMU
template <bool SPLIT, int lda0, int lda1, int ksp, class Epi>
__device__ __forceinline__ void gemm_phase(const h16* A0, const h16* A1,
                                           const h16* Bt, int M, int N, char* smem, const Epi& epi) {
  const int nM = M / 256, nN = N / 256, ntile = nM * nN;
  for (int tile = blockIdx.x; tile < ntile; tile += gridDim.x) {
    int pm, pn; gemm_tile_coords(tile, nM, nN, pm, pn);
    __syncthreads();
    gemm_tile<SPLIT, lda0, lda1, ksp>(A0, A1, Bt, pm * 256, pn * 256, smem, epi);
  }
}
#else
template <bool SPLIT, int lda0, int lda1, int ksp, class Epi>
__device__ __forceinline__ void gemm_phase(const h16* A0, const h16* A1,
                                           const h16* Bt, int M, int N, char* smem, const Epi& epi) {
  constexpr int K = D;
  constexpr int nt = K / G_BK;
  static_assert(nt % 2 == 0 && nt >= 4, "K tiles");
  const int nM = M / 256, nN = N / 256, ntile = nM * nN;
  const int xcd_ = blockIdx.x & 7, slot_ = blockIdx.x >> 3, gstep_ = ((int)gridDim.x >> 3) * 8 * 32 / 32;
  (void)gstep_;
  int rnd_ = 0;
  int tile = (rnd_ * 8 + xcd_) * ((int)gridDim.x >> 3) + slot_;
  __syncthreads();
  if (tile >= ntile) return;
  h16* shm = (h16*)smem;
  #define SA(b,h) (shm+((b)*2+(h))*G_HT)
  #define SB(b,h) (shm+(4+(b)*2+(h))*G_HT)
  #define APTR(kt) ((!SPLIT || (kt) < ksp) ? A0 + (long)(kt) * G_BK : A1 + (long)((kt) - ksp) * G_BK)
  #define ALD(kt) ((!SPLIT || (kt) < ksp) ? lda0 : lda1)
  #define STAGE_A(T,P_,br,kt) do{ const h16* _base = APTR(kt); long _ld = ALD(kt); \
    for(int _i=0;_i<2;++_i){int _b=(T)*16+_i*8192;int _r,_c;g_stage_rc(_b,_r,_c); \
      __builtin_amdgcn_global_load_lds((const unsigned*)(_base+(long)((br)+_r)*_ld+_c), \
        (unsigned*)((char*)(P_)+_b),16,0,0);}}while(0)
  #define STAGE_B(T,P_,br,kt) do{long _g=(long)(br)*K+(long)(kt)*G_BK; \
    for(int _i=0;_i<2;++_i){int _b=(T)*16+_i*8192;int _r,_c;g_stage_rc(_b,_r,_c); \
      __builtin_amdgcn_global_load_lds((const unsigned*)(Bt+_g+(long)_r*K+_c), \
        (unsigned*)((char*)(P_)+_b),16,0,0);}}while(0)
  #define LDA(dst,b,h) for(int m=0;m<4;++m)for(int k=0;k<2;++k) \
    dst[m][k]=*reinterpret_cast<const h16x8*>((char*)SA(b,h)+g_lds_byte(wr*64+m*16+fr,k*32+fq*8))
  #define LDB(dst,b,h) for(int n=0;n<2;++n)for(int k=0;k<2;++k) \
    dst[n][k]=*reinterpret_cast<const h16x8*>((char*)SB(b,h)+g_lds_byte(wc*32+n*16+fr,k*32+fq*8))
  #define MMA(ai,bj,At_,Bt_) do{__builtin_amdgcn_s_setprio(1); \
    for(int m=0;m<4;++m)for(int n=0;n<2;++n)for(int k=0;k<2;++k) \
      acc[ai][bj][m][n]=__builtin_amdgcn_mfma_f32_16x16x32_f16(Bt_[n][k],At_[m][k],acc[ai][bj][m][n],0,0,0); \
    __builtin_amdgcn_s_setprio(0);}while(0)
  #define WAIT_V(n) asm volatile("s_waitcnt vmcnt(" #n ")":::"memory")
  #define WAIT_L(n) asm volatile("s_waitcnt lgkmcnt(" #n ")":::"memory")
  #define BAR __builtin_amdgcn_s_barrier()
  #define SCHED __builtin_amdgcn_sched_barrier(0)
  int pm, pn; gemm_tile_coords(tile, nM, nN, pm, pn);
  int brow = __builtin_amdgcn_readfirstlane(pm) * 256, bcol = __builtin_amdgcn_readfirstlane(pn) * 256;
  {
    const int tx = TIDX; const int wr = tx >> 8;
    STAGE_B(tx,SB(0,0),bcol,0); STAGE_A(tx,SA(0,0),brow,0);
    STAGE_B(tx,SB(0,1),bcol+G_HALF,0); STAGE_A(tx,SA(0,1),brow+G_HALF,0);
    if(wr==1)BAR;
    WAIT_V(4); BAR;
    STAGE_B(tx,SB(1,0),bcol,1); STAGE_A(tx,SA(1,0),brow,1); STAGE_B(tx,SB(1,1),bcol+G_HALF,1);
    WAIT_V(6); BAR;
  }
  for (;;) {
    const int nxt = ((rnd_ + 1) * 8 + xcd_) * ((int)gridDim.x >> 3) + slot_;
    const bool has_next = nxt < ntile;
    int qm, qn; gemm_tile_coords(has_next ? nxt : tile, nM, nN, qm, qn);
    const int nbrow = __builtin_amdgcn_readfirstlane(qm) * 256, nbcol = __builtin_amdgcn_readfirstlane(qn) * 256;
    int tx = TIDX;
    int wid=tx>>6,lane=tx&63,wr=wid>>2,wc=wid&3,fr=lane&15,fq=lane>>4;
    f32x4 acc[2][2][4][2]={};
    h16x8 At[4][2],B0[2][2],B1[2][2];
    for(int t=0;t<nt;t+=2){
      const bool wrap = t + 2 >= nt;
      const int r2 = wrap ? nbrow : brow, c2 = wrap ? nbcol : bcol, k2 = wrap ? 0 : t + 2, k3 = k2 + 1;
      LDB(B0,0,0); SCHED; LDA(At,0,0); STAGE_A(tx,SA(1,1),brow+G_HALF,t+1);
      WAIT_L(8); BAR; WAIT_L(0); MMA(0,0,At,B0); BAR; SCHED;
      LDB(B1,0,1); STAGE_B(tx,SB(0,0),c2,k2);
      BAR; WAIT_L(0); MMA(0,1,At,B1); BAR;
      LDA(At,0,1); STAGE_A(tx,SA(0,0),r2,k2);
      BAR; WAIT_L(0); MMA(1,0,At,B0); BAR; SCHED;
      STAGE_B(tx,SB(0,1),c2+G_HALF,k2);
      WAIT_V(6); BAR; MMA(1,1,At,B1); BAR;
      LDB(B0,1,0); SCHED; LDA(At,1,0); STAGE_A(tx,SA(0,1),r2+G_HALF,k2);
      WAIT_L(8); BAR; WAIT_L(0); MMA(0,0,At,B0); BAR; SCHED;
      LDB(B1,1,1); STAGE_B(tx,SB(1,0),c2,k3);
      BAR; WAIT_L(0); MMA(0,1,At,B1); BAR;
      LDA(At,1,1); STAGE_A(tx,SA(1,0),r2,k3);
      BAR; WAIT_L(0); MMA(1,0,At,B0); BAR; SCHED;
      STAGE_B(tx,SB(1,1),c2+G_HALF,k3);
      WAIT_V(6); BAR; MMA(1,1,At,B1); BAR;
    }
    int tz=TIDX; wid=tz>>6; lane=tz&63; wr=wid>>2; wc=wid&3; fr=lane&15; fq=lane>>4;
    _Pragma("unroll") for(int ai=0;ai<2;++ai) _Pragma("unroll") for(int bj=0;bj<2;++bj) _Pragma("unroll") for(int m=0;m<4;++m) _Pragma("unroll") for(int n=0;n<2;++n)
      epi(brow+ai*G_HALF+wr*64+m*16+fr, bcol+bj*G_HALF+wc*32+n*16+fq*4, acc[ai][bj][m][n]);
    if (!has_next) break;
    tile = nxt; brow = nbrow; bcol = nbcol; ++rnd_;
  }
  WAIT_V(0);
  { const int tq = TIDX; if ((tq >> 8) == 0) BAR; }
  __syncthreads();
  #undef SA
  #undef SB
  #undef APTR
  #undef ALD
  #undef STAGE_A
  #undef STAGE_B
  #undef LDA
  #undef LDB
  #undef MMA
  #undef WAIT_V
  #undef WAIT_L
  #undef BAR
  #undef SCHED
}
#endif

struct EpiStoreH16 { h16* C; int ldc; int ncols;
  __device__ __forceinline__ void operator()(int r, int c, f32x4 v) const {
    if (c < ncols) { h16x4 o; o[0] = (h16)v[0]; o[1] = (h16)v[1]; o[2] = (h16)v[2]; o[3] = (h16)v[3]; *(h16x4*)(C + (size_t)r * ldc + c) = o; } } };
struct EpiStoreF32 { float* C; int ldc;
  __device__ __forceinline__ void operator()(int r, int c, f32x4 v) const { *(f32x4*)(C + (size_t)r * ldc + c) = v; } };
struct EpiOddIn { h16* prw; h16* plru;
  __device__ __forceinline__ void operator()(int r, int c, f32x4 v) const {
    h16x4 o; o[0] = (h16)v[0]; o[1] = (h16)v[1]; o[2] = (h16)v[2]; o[3] = (h16)v[3];
    if (c < RW_SHIFT) *(h16x4*)(prw + (size_t)r * RW_SHIFT + c) = o;
    else if (c < ODD_IN) *(h16x4*)(plru + (size_t)r * (2 * LRUW) + (c - RW_SHIFT)) = o; } };
static_assert(RW_SHIFT % 4 == 0 && ODD_IN % 4 == 0 && EVEN_IN % 4 == 0, "vector epilogue");

__device__ __forceinline__ void task_transpose(const float* W, h16* Wt, int K, int N, int unit, char* smem) {
  float* tile = (float*)smem;
  const int nkt = K / 64;
  const int kt = unit % nkt, ntile = unit / nkt;
  const int k0 = kt * 64, n0 = ntile * 64;
  __syncthreads();
#pragma unroll 4
  for (int i = TIDX; i < 64 * 64; i += NTHR) {
    int kk = i / 64, nn = i % 64;
    tile[kk * 65 + nn] = (n0 + nn < N) ? W[(size_t)(k0 + kk) * N + n0 + nn] : 0.f;
  }
  __syncthreads();
  for (int i = TIDX; i < 64 * 64; i += NTHR) {
    int nn = i / 64, kk = i % 64;
    Wt[(size_t)(n0 + nn) * K + k0 + kk] = (h16)tile[kk * 65 + nn];
  }
}
__device__ __forceinline__ void task_convert(const float* src, h16* dst, size_t n, int unit, int nunits) {
  size_t n4 = n / 4;
  for (size_t i = (size_t)unit * NTHR + TIDX; i < n4; i += (size_t)nunits * NTHR) {
    const float4 v = ((const float4*)src)[i];
    h16x4 o; o[0] = (h16)v.x; o[1] = (h16)v.y; o[2] = (h16)v.z; o[3] = (h16)v.w;
    ((h16x4*)dst)[i] = o;
  }
}

__device__ __forceinline__ void task_mod(const Params& P, int unit, char* smem) {
  float* sc = (float*)smem;
  float* part = sc + 3 * D;
  const int tid = TIDX, wave = tid >> 6, lane = tid & 63;
  __syncthreads();
  for (int i = tid; i < 3 * D; i += NTHR) {
    int r = i / D, k = i % D;
    float v = r < BATCH ? P.c[r * D + k] : P.c_ctx[k];
    sc[i] = siluf_(v);
  }
  __syncthreads();
  const int idx = unit * 64 + lane;
  const int l = idx / D6, j = idx % D6;
  const float* w = P.ada_w + (size_t)l * D * D6 + j;
  float a0 = 0, a1 = 0, a2 = 0;
  constexpr int KW = D / 8;
#pragma unroll 8
  for (int k = wave * KW; k < (wave + 1) * KW; ++k) { const float wv = w[(size_t)k * D6]; a0 += sc[k] * wv; a1 += sc[D + k] * wv; a2 += sc[2 * D + k] * wv; }
  part[(wave * 3 + 0) * 64 + lane] = a0; part[(wave * 3 + 1) * 64 + lane] = a1; part[(wave * 3 + 2) * 64 + lane] = a2;
  __syncthreads();
  if (tid < 192) {
    const int r = tid / 64, jj = tid % 64;
    float s = 0.f;
#pragma unroll
    for (int wv = 0; wv < 8; ++wv) s += part[(wv * 3 + r) * 64 + jj];
    const int id2 = unit * 64 + jj, l2 = id2 / D6, j2 = id2 % D6;
    float* mod = (float*)(P.ws + O_MOD);
    mod[(size_t)(l2 * 3 + r) * D6 + j2] = s + P.ada_b[l2 * D6 + j2];
  }
}
static_assert(BATCH == 2, "mod rows");

__device__ __forceinline__ void task_tables(const Params& P, int unit) {
  float* rc = (float*)(P.ws + O_ROPE);
  float* rs = rc + (size_t)(SEQ + CTX_LEN) * 64;
  const int nrope = (SEQ + CTX_LEN) * 64;
  int i = unit * NTHR + TIDX;
  if (i < nrope) {
    int pos = i / 64, f = i % 64;
    float rowv, colv;
    if (pos < SEQ) { rowv = (float)(pos / GRID_W); colv = (float)(pos % GRID_W); }
    else { rowv = (float)((pos - SEQ) - CTX_LEN); colv = 0.f; }
    const int nf = RET_HD / 4;
    int fi = f % nf;
    float freq = powf(10000.0f, -(float)fi / (float)nf);
    float ang = (f < nf ? rowv : colv) * freq;
    rc[i] = cosf(ang); rs[i] = sinf(ang);
  }
  int j = i - nrope;
  if (j >= 0 && j < SEQ / 2) {
    float2* tw = (float2*)(P.ws + O_TW);
    float s, c;
    sincospif(-2.0f * (float)j / (float)SEQ, &s, &c);
    tw[j] = make_float2(c, s);
  }
}

__device__ __forceinline__ void task_h3(const Params& P, int unit, char* smem) {
  float* hin = (float*)smem;
  float* hout = hin + 8 * 64;
  float* h3 = (float*)(P.ws + O_H3);
  const int pl = TIDX / 64, j = TIDX % 64;
  const int gp = unit * 8 + pl;
  const bool isc = gp >= SEQ;
  const int L = isc ? CTX_LEN : SEQ;
  const int pos = isc ? gp - SEQ : gp;
  const float t = (float)pos / (float)(L - 1);
  const float fr = P.f_freq[j];
  __syncthreads();
  float acc = P.f_b1[j];
  acc += t * P.f_w1[0 * FH + j];
#pragma unroll 1
  for (int b = 0; b < 16; ++b) {
    float band = 1e-4f + (15.0f - 1e-4f) * (float)b / 15.0f;
    float s, c;
    sincospif(2.0f * (float)pos * band / (float)L, &s, &c);
    acc += c * P.f_w1[(1 + b) * FH + j];
    acc += (-s) * P.f_w1[(17 + b) * FH + j];
  }
  hin[pl * 64 + j] = sinf(fr * acc);
  __syncthreads();
  acc = P.f_b2[j];
#pragma unroll 8
  for (int i = 0; i < FH; ++i) acc += hin[pl * 64 + i] * P.f_w2[i * FH + j];
  hout[pl * 64 + j] = sinf(fr * acc);
  __syncthreads();
  acc = P.f_b3[j];
#pragma unroll 8
  for (int i = 0; i < FH; ++i) acc += hout[pl * 64 + i] * P.f_w3[i * FH + j];
  if (gp < SEQ + CTX_LEN) h3[(size_t)gp * FH + j] = sinf(fr * acc);
}
static_assert((SEQ + CTX_LEN) % 8 == 0, "h3 units");

constexpr int P6_NB = D / 32;
constexpr int P6_ROWB = P6_NB * 24 + P6_NB;
typedef unsigned u32x6 __attribute__((ext_vector_type(6)));
typedef float f32x32 __attribute__((ext_vector_type(32)));
typedef float f32x16 __attribute__((ext_vector_type(16)));
__device__ __forceinline__ float p6_scale_from_byte(unsigned b) { return __builtin_bit_cast(float, b << 23); }
__device__ __forceinline__ unsigned p6_scale_byte(float amax) {
  const unsigned e = (__builtin_bit_cast(unsigned, amax) >> 23) & 255u;
  int sb = (int)e - 2; if (sb < 1) sb = 1; if (sb > 254) sb = 254;
  return (unsigned)sb;
}
#ifdef EMU
__device__ __forceinline__ unsigned p6_enc1(float x) {
  const unsigned sgn = x < 0.f ? 32u : 0u; float a = fabsf(x);
  if (!(a == a)) a = 0.f;
  if (a >= 7.5f) return sgn | 31u;
  if (a < 1.f) { int m = (int)nearbyintf(a * 8.f); return sgn | (unsigned)m; }
  int e = a < 2.f ? 1 : a < 4.f ? 2 : 3;
  const float base = (float)(1 << (e - 1)), step = base / 8.f;
  int m = (int)nearbyintf((a - base) / step);
  unsigned code = (unsigned)(e * 8 + m);
  if (code > 31u) code = 31u;
  return sgn | code;
}
__device__ __forceinline__ float p6_dec1(unsigned c) {
  const unsigned e = (c >> 3) & 3u, m = c & 7u;
  const float v = e == 0 ? (float)m * 0.125f : (1.f + (float)m * 0.125f) * (float)(1 << (e - 1));
  return (c & 32u) ? -v : v;
}
__device__ __forceinline__ u32x6 p6_encode32(const float* x, float scale) {
  unsigned long long lo = 0, mid = 0, hi = 0;
  u32x6 r = (u32x6){0, 0, 0, 0, 0, 0};
  for (int i = 0; i < 32; ++i) { const unsigned c = p6_enc1(x[i] / scale); const int bit = i * 6; r[bit / 32] |= c << (bit % 32); if (bit % 32 > 26) r[bit / 32 + 1] |= c >> (32 - bit % 32); }
  (void)lo; (void)mid; (void)hi;
  return r;
}
__device__ __forceinline__ void p6_decode32(u32x6 w, float scale, float* o) {
  for (int i = 0; i < 32; ++i) { const int bit = i * 6; unsigned c = w[bit / 32] >> (bit % 32); if (bit % 32 > 26) c |= w[bit / 32 + 1] << (32 - bit % 32); o[i] = p6_dec1(c & 63u) * scale; }
}
#else
__device__ __forceinline__ u32x6 p6_encode32(const float* x, float scale) {
  f32x16 a, b;
#pragma unroll
  for (int i = 0; i < 16; ++i) { a[i] = x[2 * i]; b[i] = x[2 * i + 1]; }
  return __builtin_amdgcn_cvt_scalef32_2xpk16_fp6_f32(a, b, scale);
}
__device__ __forceinline__ void p6_decode32(u32x6 w, float scale, float* o) {
  const f32x32 r = __builtin_amdgcn_cvt_scalef32_pk32_f32_fp6(w, scale);
#pragma unroll
  for (int i = 0; i < 32; ++i) o[i] = r[i];
}
#endif
__device__ __forceinline__ void task_convert_fp6(const float* src, unsigned char* dst, int nrows, int unit, int nunits) {
  const size_t nblk = (size_t)nrows * P6_NB;
  for (size_t i = (size_t)unit * NTHR + TIDX; i < nblk; i += (size_t)nunits * NTHR) {
    const size_t row = i / P6_NB; const int blk = (int)(i % P6_NB);
    const float* sp = src + row * D + blk * 32;
    float x[32]; float amax = 0.f;
#pragma unroll
    for (int q = 0; q < 8; ++q) {
      const float4 v = *(const float4*)(sp + q * 4);
      x[q * 4] = v.x; x[q * 4 + 1] = v.y; x[q * 4 + 2] = v.z; x[q * 4 + 3] = v.w;
      amax = fmaxf(amax, fmaxf(fmaxf(fabsf(v.x), fabsf(v.y)), fmaxf(fabsf(v.z), fabsf(v.w))));
    }
    const unsigned sb = p6_scale_byte(amax);
    const u32x6 w = p6_encode32(x, p6_scale_from_byte(sb));
    unsigned char* rp = dst + row * P6_ROWB;
    unsigned* wp = (unsigned*)(rp + blk * 24);
#pragma unroll
    for (int q = 0; q < 6; ++q) wp[q] = w[q];
    rp[P6_NB * 24 + blk] = (unsigned char)sb;
  }
}
constexpr int U_MOD = 2 * D6 / 64;
static_assert(D6 % 64 == 0 && D % 8 == 0, "mod units");
constexpr int U_TAB = ((SEQ + CTX_LEN) * 64 + SEQ / 2 + NTHR - 1) / NTHR;
constexpr int U_H3 = (SEQ + CTX_LEN) / 8;
constexpr int U_CONV = 2048;

__device__ __forceinline__ void convert_layer_weights(const Params& P, int layer, char* smem) {
  const float* win = layer == 0 ? P.ev_w_in : P.od_w_in;
  const int nin = layer == 0 ? EVEN_IN : ODD_IN;
  const int npin = layer == 0 ? NP_EV : NP_OD;
  const float* wout = layer == 0 ? P.ev_w_out : P.od_w_out;
  const float* wq = P.peer_wq + (size_t)layer * D * QW;
  const int u_in = (D / 64) * (npin / 64), u_out = (D / 64) * (D / 64), u_q = (D / 64) * (QW / 64);
  const int total = u_in + u_out + u_q + 2 * U_CONV + 8;
  for (int u = blockIdx.x; u < total; u += gridDim.x) {
    int v = u;
    if (v < u_in) { task_transpose(win, (h16*)(P.ws + O_WIN), D, nin, v, smem); continue; }
    v -= u_in;
    if (v < u_out) { task_transpose(wout, (h16*)(P.ws + O_WOUT), D, D, v, smem); continue; }
    v -= u_out;
    if (v < u_q) { task_transpose(wq, (h16*)(P.ws + O_WQ), D, QW, v, smem); continue; }
    v -= u_q;
    if (v < U_CONV) { task_convert_fp6(P.peer_u + (size_t)layer * PEER_E * D, (unsigned char*)(P.ws + O_TABU), PEER_E, v, U_CONV); continue; }
    v -= U_CONV;
    if (v < U_CONV) { task_convert_fp6(P.peer_v + (size_t)layer * PEER_E * D, (unsigned char*)(P.ws + O_TABV), PEER_E, v, U_CONV); continue; }
    v -= U_CONV;
    task_convert(P.peer_keys + (size_t)layer * PEER_H * 2 * PEER_KEYS * 128, (h16*)(P.ws + O_KEYS16), (size_t)PEER_H * 2 * PEER_KEYS * 128, v, 8);
  }
  if (layer == 1) {
    h16* lw = (h16*)(P.ws + O_LW16);
    for (size_t i = (size_t)blockIdx.x * NTHR + TIDX; i < (size_t)2 * LRU_BLOCKS * 2 * 64 * 64; i += (size_t)gridDim.x * NTHR) {
      const int ii = (int)(i % 64), j = (int)((i / 64) % 64), m = (int)((i / 4096) % 2), db = (int)(i / 8192);
      const float* src = (m == 0 ? P.lru_wa : P.lru_wx) + (size_t)db * 64 * 64;
      lw[i] = (h16)src[ii * 64 + j];
    }
    h16* rw = (h16*)(P.ws + O_RW16);
    for (size_t i = (size_t)blockIdx.x * NTHR + TIDX; i < (size_t)2 * 2 * RWW * 64; i += (size_t)gridDim.x * NTHR) {
      const int k = (int)(i % 64), nn = (int)((i / 64) % RWW), m = (int)((i / (64 * (size_t)RWW)) % 2), d = (int)(i / (2 * 64 * (size_t)RWW));
      const float* src = (m == 0 ? P.rw_w2 : P.rw_a2) + (size_t)d * 64 * RWW;
      rw[i] = (h16)src[(size_t)k * RWW + nn];
    }
    h16* g2t = (h16*)(P.ws + O_G216);
    for (size_t i = (size_t)blockIdx.x * NTHR + TIDX; i < (size_t)RWW * 160; i += (size_t)gridDim.x * NTHR) {
      const int k = (int)(i % 160), nn = (int)(i / 160);
      g2t[i] = (h16)P.rw_g2[(size_t)k * RWW + nn];
    }
  }
}

__device__ __forceinline__ void ph_prologue(const Params& P, char* smem) {
  const int total = U_MOD + U_TAB + U_H3;
  for (int u = blockIdx.x; u < total; u += gridDim.x) {
    int v = u;
    if (v < U_MOD) { task_mod(P, v, smem); continue; }
    v -= U_MOD;
    if (v < U_TAB) { task_tables(P, v); continue; }
    v -= U_TAB;
    task_h3(P, v, smem);
  }
  convert_layer_weights(P, 0, smem);
}

__device__ __forceinline__ void ph_modulate0(const Params& P) {
  h16* A = (h16*)(P.ws + O_ABUF);
  const size_t n4 = (size_t)NT * D / 4;
  for (size_t i = (size_t)blockIdx.x * NTHR + TIDX; i < n4; i += (size_t)gridDim.x * NTHR) {
    const size_t e = i * 4;
    const int row = (int)(e / D), k = (int)(e % D);
    const float* src = row < NL ? P.x + (size_t)row * D : P.ctx + (size_t)(row - NL) * D;
    const float4 v = *(const float4*)(src + k);
    const float* sh = mod_ptr(P, 0, row, 0) + k;
    const float* sc = mod_ptr(P, 0, row, 1) + k;
    h16x4 o;
    o[0] = (h16)(v.x * (1.f + sc[0]) + sh[0]); o[1] = (h16)(v.y * (1.f + sc[1]) + sh[1]);
    o[2] = (h16)(v.z * (1.f + sc[2]) + sh[2]); o[3] = (h16)(v.w * (1.f + sc[3]) + sh[3]);
    *(h16x4*)(A + e) = o;
  }
}

__device__ __forceinline__ void ph_filter(const Params& P, char* smem) {
  float* h3s = (float*)smem;
  float* w4s = h3s + 64 * 65;
  const float* h3 = (const float*)(P.ws + O_H3);
  float* filt = (float*)(P.ws + O_FILT);
  float* filtc = (float*)(P.ws + O_FILTC);
  constexpr int NTT = (SEQ + CTX_LEN) / 64, NCT = HY_CH / 64;
  const float max_decay = logf(1e-2f) / 0.3f, min_decay = logf(1e-2f) / 1.5f;
  for (int u = blockIdx.x; u < NTT * NCT; u += gridDim.x) {
    const int tt = u % NTT, ct = u / NTT;
    const int gp0 = tt * 64, c0 = ct * 64;
    const bool isc = gp0 >= SEQ;
    const int L = isc ? CTX_LEN : SEQ;
    const int t0 = isc ? gp0 - SEQ : gp0;
    __syncthreads();
    for (int i = TIDX; i < 64 * 64; i += NTHR) { int t = i / 64, j = i % 64; h3s[t * 65 + j] = h3[(size_t)(gp0 + t) * FH + j]; }
    for (int i = TIDX; i < 64 * 128; i += NTHR) {
      int j = i / 128, col = i % 128, cc = col / 2, dir = col % 2;
      w4s[j * 128 + col] = P.f_w4[(size_t)j * (2 * HY_CH) + dir * HY_CH + c0 + cc];
    }
    __syncthreads();
    const int t = TIDX % 64, cg = TIDX / 64;
    float acc[16];
#pragma unroll
    for (int q = 0; q < 16; ++q) acc[q] = 0.f;
    for (int j = 0; j < 64; ++j) {
      const float h = h3s[t * 65 + j];
#pragma unroll
      for (int q = 0; q < 16; ++q) acc[q] += h * w4s[j * 128 + cg * 16 + q];
    }
    const float tn = (float)(t0 + t) / (float)(L - 1);
#pragma unroll
    for (int q = 0; q < 16; ++q) {
      const int col = cg * 16 + q, cc = col / 2, dir = col % 2, c = c0 + cc;
      const float delta = fabsf(min_decay + (max_decay - min_decay) * (float)c / (float)(HY_CH - 1));
      const float v = (acc[q] + P.f_b4[dir * HY_CH + c]) * expf(-tn * delta);
      if (isc) filtc[((size_t)c * 2 + dir) * CTX_LEN + t0 + t] = v;
      else filt[((size_t)c * 2 + dir) * SEQ + t0 + t] = v;
    }
  }
}

__device__ __forceinline__ float hy_short(const Params& P, const h16* p, int rbase, int L, int t, int col) {
  float acc = P.hy_short_b[col];
#pragma unroll
  for (int k = 0; k < 3; ++k) {
    int tt = t + k - 1;
    if (tt >= 0 && tt < L) acc += P.hy_short_w[k * (3 * HY_CH) + col] * (float)p[(size_t)(rbase + tt) * NP_EV + col];
  }
  return acc;
}

__device__ __forceinline__ void hy_short8(const Params& P, const h16* p, int rbase, int L, int t, int col0, float* out) {
  const float4 b0 = *(const float4*)(P.hy_short_b + col0), b1 = *(const float4*)(P.hy_short_b + col0 + 4);
  out[0] = b0.x; out[1] = b0.y; out[2] = b0.z; out[3] = b0.w; out[4] = b1.x; out[5] = b1.y; out[6] = b1.z; out[7] = b1.w;
#pragma unroll
  for (int k = 0; k < 3; ++k) {
    const int tt = t + k - 1;
    if (tt >= 0 && tt < L) {
      const h16x8 pv = *(const h16x8*)(p + (size_t)(rbase + tt) * NP_EV + col0);
      const float4 w0 = *(const float4*)(P.hy_short_w + k * (3 * HY_CH) + col0), w1 = *(const float4*)(P.hy_short_w + k * (3 * HY_CH) + col0 + 4);
      out[0] += w0.x * (float)pv[0]; out[1] += w0.y * (float)pv[1]; out[2] += w0.z * (float)pv[2]; out[3] += w0.w * (float)pv[3];
      out[4] += w1.x * (float)pv[4]; out[5] += w1.y * (float)pv[5]; out[6] += w1.z * (float)pv[6]; out[7] += w1.w * (float)pv[7];
    }
  }
}

__device__ __forceinline__ void ph_hyena_pre(const Params& P, char* smem) {
  float* zs = (float*)smem;
  const h16* p = (const h16*)(P.ws + O_P0);
  h16* zT = (h16*)P.out;
  constexpr int NTT = SEQ / 64, NCT = HY_CH / 64;
  for (int u = blockIdx.x; u < BATCH * NTT * NCT; u += gridDim.x) {
    const int ct = u % NCT, tt = (u / NCT) % NTT, b = u / (NCT * NTT);
    const int t0 = tt * 64, c0 = ct * 64;
    __syncthreads();
    {
      const int i = TIDX, t = i / 8, c8 = (i % 8) * 8;
      float x1[8], v[8];
      hy_short8(P, p, b * SEQ, SEQ, t0 + t, HY_CH + c0 + c8, x1);
      hy_short8(P, p, b * SEQ, SEQ, t0 + t, 2 * HY_CH + c0 + c8, v);
#pragma unroll
      for (int j = 0; j < 8; ++j) zs[t * 65 + c8 + j] = x1[j] * v[j];
    }
    __syncthreads();
#pragma unroll 4
    for (int i = TIDX; i < 64 * 64; i += NTHR) {
      int c = i / 64, t = i % 64;
      zT[((size_t)(c0 + c) * BATCH + b) * SEQ + t0 + t] = (h16)zs[t * 65 + c];
    }
  }
}

__device__ __forceinline__ float2 cmul_(float2 a, float2 w) { return make_float2(a.x * w.x - a.y * w.y, a.x * w.y + a.y * w.x); }
__device__ __forceinline__ float2 cmulc_(float2 a, float2 w) { return make_float2(a.x * w.x + a.y * w.y, a.y * w.x - a.x * w.y); }
constexpr int FFT_LOG = __builtin_ctz(SEQ);
__device__ __forceinline__ void fft_r2(float2* X, const float2* tw, int lh, bool inv) {
  const int h = 1 << lh, tsh = (FFT_LOG - 1) - lh;
  __syncthreads();
#pragma unroll 4
  for (int m = TIDX; m < SEQ / 2; m += NTHR) {
    const int j = m & (h - 1), i = ((m >> lh) << (lh + 1)) + j;
    const float2 a = X[i], b = X[i + h], w = tw[j << tsh];
    if (!inv) { X[i] = make_float2(a.x + b.x, a.y + b.y); X[i + h] = cmul_(make_float2(a.x - b.x, a.y - b.y), w); }
    else { const float2 bw = cmulc_(b, w); X[i] = make_float2(a.x + bw.x, a.y + bw.y); X[i + h] = make_float2(a.x - bw.x, a.y - bw.y); }
  }
}
__device__ __forceinline__ void fft_fwd(float2* X, const float2* tw) {
  int lh = FFT_LOG - 1;
  if (FFT_LOG & 1) { fft_r2(X, tw, lh, false); --lh; }
  for (; lh >= 1; lh -= 2) {
    const int lq = lh - 1, q = 1 << lq;
    const int tsh = (FFT_LOG - 2) - lq;
    __syncthreads();
#pragma unroll 2
    for (int m = TIDX; m < SEQ / 4; m += NTHR) {
      const int j = m & (q - 1), i = ((m >> lq) << (lq + 2)) + j;
      const float2 x0 = X[i], x1 = X[i + q], x2 = X[i + 2 * q], x3 = X[i + 3 * q];
      const float2 w1 = tw[j << tsh], w2 = tw[(2 * j) << tsh];
      const float2 a = make_float2(x0.x + x2.x, x0.y + x2.y), bq = make_float2(x0.x - x2.x, x0.y - x2.y);
      const float2 c = make_float2(x1.x + x3.x, x1.y + x3.y), d = make_float2(x1.y - x3.y, -(x1.x - x3.x));
      X[i] = make_float2(a.x + c.x, a.y + c.y);
      X[i + q] = cmul_(make_float2(a.x - c.x, a.y - c.y), w2);
      X[i + 2 * q] = cmul_(make_float2(bq.x + d.x, bq.y + d.y), w1);
      X[i + 3 * q] = cmul_(make_float2(bq.x - d.x, bq.y - d.y), cmul_(w1, w2));
    }
  }
  __syncthreads();
}
__device__ __forceinline__ void fft_inv(float2* X, const float2* tw) {
  int lq = 0;
  for (; lq + 1 <= FFT_LOG - 1; lq += 2) {
    const int q = 1 << lq;
    const int tsh = (FFT_LOG - 2) - lq;
    __syncthreads();
#pragma unroll 2
    for (int m = TIDX; m < SEQ / 4; m += NTHR) {
      const int j = m & (q - 1), i = ((m >> lq) << (lq + 2)) + j;
      const float2 x0 = X[i], x1 = X[i + q], x2 = X[i + 2 * q], x3 = X[i + 3 * q];
      const float2 w1 = tw[j << tsh], w2 = tw[(2 * j) << tsh];
      const float2 t1 = cmulc_(x1, w2), t3 = cmulc_(x3, w2);
      const float2 p0 = make_float2(x0.x + t1.x, x0.y + t1.y), p1 = make_float2(x0.x - t1.x, x0.y - t1.y);
      const float2 p2 = cmulc_(make_float2(x2.x + t3.x, x2.y + t3.y), w1), p3w = cmulc_(make_float2(x2.x - t3.x, x2.y - t3.y), w1);
      const float2 p3 = make_float2(-p3w.y, p3w.x);
      X[i] = make_float2(p0.x + p2.x, p0.y + p2.y);
      X[i + 2 * q] = make_float2(p0.x - p2.x, p0.y - p2.y);
      X[i + q] = make_float2(p1.x + p3.x, p1.y + p3.y);
      X[i + 3 * q] = make_float2(p1.x - p3.x, p1.y - p3.y);
    }
  }
  if (FFT_LOG & 1) fft_r2(X, tw, FFT_LOG - 1, true);
  __syncthreads();
}

__device__ __forceinline__ void ph_hyena_fft(const Params& P, char* smem) {
  float2* X = (float2*)smem;
  const float2* tw = (const float2*)(P.ws + O_TW);
  const float* filt = (const float*)(P.ws + O_FILT);
  float2* scr = (float2*)(P.ws + O_FFTS) + (size_t)blockIdx.x * 2 * SEQ;
  h16* zT = (h16*)P.out;
  constexpr int L = SEQ;
  for (int c = blockIdx.x; c < HY_CH; c += gridDim.x) {
    const float* g0 = filt + ((size_t)c * 2 + 0) * L;
    const float* g1 = filt + ((size_t)c * 2 + 1) * L;
    h16* z0 = zT + ((size_t)c * BATCH + 0) * L;
    h16* z1 = zT + ((size_t)c * BATCH + 1) * L;
    __syncthreads();
    for (int n = TIDX; n < L; n += NTHR) {
      const float gb = n == 0 ? 0.f : g1[L - n];
      X[n] = make_float2(g0[n] + gb, 0.f);
    }
    fft_fwd(X, tw);
    for (int n = TIDX; n < L; n += NTHR) scr[n] = X[n];
    __syncthreads();
    for (int n = TIDX; n < L; n += NTHR) {
      const float gb = n == 0 ? 0.f : g1[L - n];
      float s, co; sincospif(-(float)n / (float)L, &s, &co);
      const float d = g0[n] - gb;
      X[n] = make_float2(d * co, d * s);
    }
    fft_fwd(X, tw);
    for (int n = TIDX; n < L; n += NTHR) scr[L + n] = X[n];
    __syncthreads();
    for (int n = TIDX; n < L; n += NTHR) X[n] = make_float2((float)z0[n], (float)z1[n]);
    fft_fwd(X, tw);
    for (int n = TIDX; n < L; n += NTHR) {
      const float2 a = X[n], f = scr[n];
      X[n] = make_float2(a.x * f.x - a.y * f.y, a.x * f.y + a.y * f.x);
    }
    fft_inv(X, tw);
    for (int n = TIDX; n < L; n += NTHR) scr[n] = X[n];
    __syncthreads();
    for (int n = TIDX; n < L; n += NTHR) {
      float s, co; sincospif(-(float)n / (float)L, &s, &co);
      const float ax = (float)z0[n], ay = (float)z1[n];
      X[n] = make_float2(ax * co - ay * s, ax * s + ay * co);
    }
    fft_fwd(X, tw);
    for (int n = TIDX; n < L; n += NTHR) {
      const float2 a = X[n], f = scr[L + n];
      X[n] = make_float2(a.x * f.x - a.y * f.y, a.x * f.y + a.y * f.x);
    }
    fft_inv(X, tw);
    const float sc = 0.5f / (float)L;
    for (int n = TIDX; n < L; n += NTHR) {
      float s, co; sincospif((float)n / (float)L, &s, &co);
      const float2 o = X[n], e = scr[n];
      const float yx = e.x + (o.x * co - o.y * s), yy = e.y + (o.x * s + o.y * co);
      z0[n] = (h16)(yx * sc); z1[n] = (h16)(yy * sc);
    }
  }
}

__device__ __forceinline__ void ph_hyena_post(const Params& P, char* smem) {
  const h16* p = (const h16*)(P.ws + O_P0);
  h16* mix = (h16*)(P.ws + O_ABUF);
  const h16* zT = (const h16*)P.out;
  constexpr int NTT = SEQ / 64, NCT = HY_CH / 64;
  constexpr int U_LAT = BATCH * NTT * NCT;
  constexpr int CT_ = 8;
  constexpr int U_CTX = BATCH * (HY_CH / CT_);
  for (int u = blockIdx.x; u < U_LAT + U_CTX; u += gridDim.x) {
    __syncthreads();
    if (u < U_LAT) {
      float* cs = (float*)smem;
      const int ct = u % NCT, tt = (u / NCT) % NTT, b = u / (NCT * NTT);
      const int t0 = tt * 64, c0 = ct * 64;
#pragma unroll 4
      for (int i = TIDX; i < 64 * 64; i += NTHR) {
        int c = i / 64, t = i % 64;
        cs[t * 65 + c] = (float)zT[((size_t)(c0 + c) * BATCH + b) * SEQ + t0 + t];
      }
      __syncthreads();
      {
        const int i = TIDX, t = i / 8, c8 = (i % 8) * 8;
        float x0[8], x1[8], v[8];
        hy_short8(P, p, b * SEQ, SEQ, t0 + t, c0 + c8, x0);
        hy_short8(P, p, b * SEQ, SEQ, t0 + t, HY_CH + c0 + c8, x1);
        hy_short8(P, p, b * SEQ, SEQ, t0 + t, 2 * HY_CH + c0 + c8, v);
        const float4 hb0 = *(const float4*)(P.hy_bias + c0 + c8), hb1 = *(const float4*)(P.hy_bias + c0 + c8 + 4);
        const float hb[8] = {hb0.x, hb0.y, hb0.z, hb0.w, hb1.x, hb1.y, hb1.z, hb1.w};
        h16x8 o;
#pragma unroll
        for (int j = 0; j < 8; ++j) o[j] = (h16)(x0[j] * (cs[t * 65 + c8 + j] + x1[j] * v[j] * hb[j]));
        *(h16x8*)(mix + (size_t)(b * SEQ + t0 + t) * D + c0 + c8) = o;
      }
    } else {
      const int v_ = u - U_LAT;
      const int ct = v_ % (HY_CH / CT_), b = v_ / (HY_CH / CT_);
      const int c0 = ct * CT_;
      float* zs = (float*)smem;
      constexpr int GLD = CTX_LEN + 1;
      float* gs = zs + CTX_LEN * (CT_ + 1);
      const float* filtc = (const float*)(P.ws + O_FILTC);
      const int rbase = NL + b * CTX_LEN;
#pragma unroll 4
      for (int i = TIDX; i < CTX_LEN * CT_; i += NTHR) {
        int t = i / CT_, c = i % CT_;
        float x1 = hy_short(P, p, rbase, CTX_LEN, t, HY_CH + c0 + c);
        float v = hy_short(P, p, rbase, CTX_LEN, t, 2 * HY_CH + c0 + c);
        zs[t * (CT_ + 1) + c] = x1 * v;
      }
      for (int i = TIDX; i < CT_ * 2 * CTX_LEN; i += NTHR) gs[(i / CTX_LEN) * GLD + i % CTX_LEN] = filtc[(size_t)c0 * 2 * CTX_LEN + i];
      __syncthreads();
      for (int i = TIDX; i < CTX_LEN * CT_; i += NTHR) {
        int t = i / CT_, c = i % CT_;
        float acc = 0.f;
        for (int s = 0; s < CTX_LEN; ++s) {
          int d = t - s;
          float g = d >= 0 ? gs[(c * 2 + 0) * GLD + d] : gs[(c * 2 + 1) * GLD - d];
          acc += zs[s * (CT_ + 1) + c] * g;
        }
        float x0 = hy_short(P, p, rbase, CTX_LEN, t, c0 + c);
        mix[(size_t)(rbase + t) * D + c0 + c] = (h16)(x0 * (acc + zs[t * (CT_ + 1) + c] * P.hy_bias[c0 + c]));
      }
    }
  }
}

__device__ __forceinline__ float ret_lg(int h, int dir) {
  int hh = dir == 0 ? h : RET_HEADS - 1 - h;
  return log1pf(-exp2f(-5.0f - (float)hh));
}
__device__ __forceinline__ int ret_chunk_row(int b, int n) {
  return n < RET_LCH ? b * SEQ + n * RET_C : NL + b * CTX_LEN + (n - RET_LCH) * RET_C;
}
__device__ __forceinline__ void ph_rope(const Params& P) {
  h16* p = (h16*)(P.ws + O_P0);
  const float* rc = (const float*)(P.ws + O_ROPE);
  const float* rs = rc + (size_t)(SEQ + CTX_LEN) * 64;
  const float kscale = 0.08838834764831845f;
  constexpr int PER_ROW = 2 * RET_HEADS * 16;
  const size_t total = (size_t)NT * PER_ROW;
#pragma unroll 2
  for (size_t i = (size_t)blockIdx.x * NTHR + TIDX; i < total; i += (size_t)gridDim.x * NTHR) {
    const int row = (int)(i / PER_ROW), it = (int)(i % PER_ROW);
    const int f4 = it % 16, hh = (it / 16) % RET_HEADS, qk = it / (16 * RET_HEADS);
    int isc, b, t; row_decode(row, isc, b, t);
    const int pos = isc ? SEQ + t : t;
    h16* pr = p + (size_t)row * NP_EV + 3 * HY_CH + qk * RETW + hh * RET_HD + f4 * 4;
    const h16x4 t1 = *(const h16x4*)pr, t2 = *(const h16x4*)(pr + 64);
    const float4 c = *(const float4*)(rc + (size_t)pos * 64 + f4 * 4), s = *(const float4*)(rs + (size_t)pos * 64 + f4 * 4);
    const float sc = qk ? kscale : 1.0f;
    h16x4 o1, o2;
    o1[0] = (h16)(((float)t1[0] * c.x - (float)t2[0] * s.x) * sc); o2[0] = (h16)(((float)t1[0] * s.x + (float)t2[0] * c.x) * sc);
    o1[1] = (h16)(((float)t1[1] * c.y - (float)t2[1] * s.y) * sc); o2[1] = (h16)(((float)t1[1] * s.y + (float)t2[1] * c.y) * sc);
    o1[2] = (h16)(((float)t1[2] * c.z - (float)t2[2] * s.z) * sc); o2[2] = (h16)(((float)t1[2] * s.z + (float)t2[2] * c.z) * sc);
    o1[3] = (h16)(((float)t1[3] * c.w - (float)t2[3] * s.w) * sc); o2[3] = (h16)(((float)t1[3] * s.w + (float)t2[3] * c.w) * sc);
    *(h16x4*)pr = o1; *(h16x4*)(pr + 64) = o2;
  }
}
__device__ __forceinline__ void ret_copy_tile(const h16* src, h16* dst, int ntok) {
#pragma unroll 4
  for (int i = TIDX; i < ntok * 16; i += NTHR) {
    const int t = i / 16, c8 = i % 16;
    *(h16x8*)(dst + t * 136 + c8 * 8) = *(const h16x8*)(src + (size_t)t * NP_EV + c8 * 8);
  }
}
__device__ __forceinline__ h16x8 frag_rows(const h16* tile, int ld, int row0, int col) {
  h16x8 f;
#pragma unroll
  for (int j = 0; j < 8; ++j) f[j] = tile[(row0 + j) * ld + col];
  return f;
}

__device__ __forceinline__ void ph_ret_inter(const Params& P, char* smem) {
  constexpr int LDR = 136;
  h16* Qs = (h16*)smem;
  h16* Ks = Qs + 128 * LDR;
  h16* Vs = Ks + 128 * LDR;
  h16* St = Vs + 128 * 24;
  float* dec = (float*)(St + 2 * 16 * LDR);
  float* wk = dec + 128;
  const h16* p = (const h16*)(P.ws + O_P0);
  h16* yint = (h16*)P.out;
  constexpr int NU = BATCH * RET_HEADS * 2 * 8;
  const int tid = TIDX, wave = tid >> 6, lane = tid & 63;
  for (int u = blockIdx.x; u < NU; u += gridDim.x) {
    const int dvs = u % 8, dir = (u / 8) % 2, h = (u / 16) % RET_HEADS, b = u / (16 * RET_HEADS);
    const float lg = ret_lg(h, dir);
    const float gC = expf(lg * (float)RET_C);
    __syncthreads();
    if (tid < 128) {
      dec[tid] = dir == 0 ? expf(lg * (float)(tid + 1)) : expf(lg * (float)(RET_C - tid));
      wk[tid] = dir == 0 ? expf(lg * (float)(RET_C - 1 - tid)) : expf(lg * (float)tid);
    }
    for (int i = tid; i < 2 * 16 * LDR; i += NTHR) St[i] = (h16)0.f;
    f32x4 accS = (f32x4){0.f, 0.f, 0.f, 0.f};
    auto chunk_of = [&](int o) -> int {
      if (o < RET_CCH) return RET_LCH + (dir == 0 ? o : RET_CCH - 1 - o);
      return dir == 0 ? (o - RET_CCH) : (RET_LCH - 1 - (o - RET_CCH));
    };
    h16x8 rq[4], rk[4], rv;
#define RI_FETCH(o_) do { const h16* pq_ = p + (size_t)ret_chunk_row(b, chunk_of(o_)) * NP_EV + 3 * HY_CH + h * RET_HD; \
      _Pragma("unroll") for (int k_ = 0; k_ < 4; ++k_) { const int i_ = tid + k_ * NTHR, t_ = i_ / 16, c8_ = i_ % 16; \
        rq[k_] = *(const h16x8*)(pq_ + (size_t)t_ * NP_EV + c8_ * 8); rk[k_] = *(const h16x8*)(pq_ + RETW + (size_t)t_ * NP_EV + c8_ * 8); } \
      if (tid < 256) rv = *(const h16x8*)(pq_ + (size_t)(tid / 2) * NP_EV + 2 * RETW + dvs * 16 + (tid % 2) * 8); } while (0)
    RI_FETCH(0);
    for (int o = 0; o < RET_NCH; ++o) {
      const int row0 = ret_chunk_row(b, chunk_of(o));
      const h16* Scur = St + (o & 1) * 16 * LDR;
      h16* Snxt = St + ((o + 1) & 1) * 16 * LDR;
      __syncthreads();
#pragma unroll
      for (int k_ = 0; k_ < 4; ++k_) {
        const int i_ = tid + k_ * NTHR, t_ = i_ / 16, c8_ = i_ % 16;
        *(h16x8*)(Qs + t_ * LDR + c8_ * 8) = rq[k_]; *(h16x8*)(Ks + t_ * LDR + c8_ * 8) = rk[k_];
      }
      if (tid < 256) {
        const int t_ = tid / 2; const float w = wk[t_];
        h16x8 o8;
#pragma unroll
        for (int j = 0; j < 8; ++j) o8[j] = (h16)(w * (float)rv[j]);
        *(h16x8*)(Vs + t_ * 24 + (tid % 2) * 8) = o8;
      }
      if (o + 1 < RET_NCH) RI_FETCH(o + 1);
      __syncthreads();
      f32x4 accY = (f32x4){0.f, 0.f, 0.f, 0.f};
      f32x4 accU = (f32x4){0.f, 0.f, 0.f, 0.f};
#pragma unroll
      for (int ks = 0; ks < 4; ++ks) {
        const int ko = ks * 32 + (lane >> 4) * 8;
        const h16x8 aq = *(const h16x8*)(Qs + (wave * 16 + (lane & 15)) * LDR + ko);
        const h16x8 bs = *(const h16x8*)(Scur + (lane & 15) * LDR + ko);
        accY = MFMA16(aq, bs, accY);
        const h16x8 ak = frag_rows(Ks, LDR, ko, wave * 16 + (lane & 15));
        const h16x8 bv = frag_rows(Vs, 24, ko, lane & 15);
        accU = MFMA16(ak, bv, accU);
      }
      h16x4 sv;
#pragma unroll
      for (int i = 0; i < 4; ++i) {
        const int j = wave * 16 + (lane >> 4) * 4 + i;
        yint[((size_t)dir * NT + row0 + j) * RETW + h * RET_HD + dvs * 16 + (lane & 15)] = (h16)(accY[i] * dec[j]);
        accS[i] = gC * accS[i] + accU[i];
        sv[i] = (h16)accS[i];
      }
      *(h16x4*)(Snxt + (lane & 15) * LDR + wave * 16 + (lane >> 4) * 4) = sv;
    }
#undef RI_FETCH
  }
}

__device__ __forceinline__ void ph_ret_out(const Params& P, char* smem) {
  constexpr int LDR = 136;
  h16* Qs = (h16*)smem;
  h16* Ks = Qs + 128 * LDR;
  h16* Vs = Ks + 128 * LDR;
  float* pf = (float*)(Vs + 128 * LDR);
  const h16* p = (const h16*)(P.ws + O_P0);
  const h16* yint = (const h16*)P.out;
  h16* mix = (h16*)(P.ws + O_ABUF);
  constexpr int NU = BATCH * RET_HEADS * RET_NCH;
  const int tid = TIDX, wave = tid >> 6, lane = tid & 63;
  for (int u = blockIdx.x; u < NU; u += gridDim.x) {
    const int n = u % RET_NCH, h = (u / RET_NCH) % RET_HEADS, b = u / (RET_NCH * RET_HEADS);
    const int row0 = ret_chunk_row(b, n);
    const float lgf = ret_lg(h, 0), lgb = ret_lg(h, 1);
    const h16* pq = p + (size_t)row0 * NP_EV + 3 * HY_CH + h * RET_HD;
    __syncthreads();
    ret_copy_tile(pq, Qs, 128);
    ret_copy_tile(pq + RETW, Ks, 128);
    ret_copy_tile(pq + 2 * RETW, Vs, 128);
    if (tid < 128) {
      pf[tid] = expf(lgf * (float)tid); pf[128 + tid] = expf(-lgf * (float)tid);
      pf[256 + tid] = expf(lgb * (float)tid); pf[384 + tid] = expf(-lgb * (float)tid);
    }
    __syncthreads();
    f32x4 acc[8];
#pragma unroll
    for (int mt = 0; mt < 8; ++mt) acc[mt] = (f32x4){0.f, 0.f, 0.f, 0.f};
#pragma unroll
    for (int ks = 0; ks < 4; ++ks) {
      const int ko = ks * 32 + (lane >> 4) * 8;
      const h16x8 aq = *(const h16x8*)(Qs + (wave * 16 + (lane & 15)) * LDR + ko);
#pragma unroll
      for (int mt = 0; mt < 8; ++mt) {
        const h16x8 bk = *(const h16x8*)(Ks + (mt * 16 + (lane & 15)) * LDR + ko);
        acc[mt] = MFMA16(aq, bk, acc[mt]);
      }
    }
#pragma unroll
    for (int mt = 0; mt < 8; ++mt) {
      const int m = mt * 16 + (lane & 15);
      const float cf = pf[128 + m], cb = pf[256 + m];
#pragma unroll
      for (int i = 0; i < 4; ++i) {
        const int qi = wave * 16 + (lane >> 4) * 4 + i;
        const float w = m <= qi ? pf[qi] * cf : cb * pf[384 + qi];
        Qs[qi * LDR + m] = (h16)(acc[mt][i] * w);
      }
    }
#ifdef EMU
    __syncthreads();
#endif
    f32x4 ya[8];
#pragma unroll
    for (int et = 0; et < 8; ++et) ya[et] = (f32x4){0.f, 0.f, 0.f, 0.f};
#pragma unroll
    for (int ks = 0; ks < 4; ++ks) {
      const int ko = ks * 32 + (lane >> 4) * 8;
      const h16x8 ap = *(const h16x8*)(Qs + (wave * 16 + (lane & 15)) * LDR + ko);
#pragma unroll
      for (int et = 0; et < 8; ++et) {
        const h16x8 bv = frag_rows(Vs, LDR, ko, et * 16 + (lane & 15));
        ya[et] = MFMA16(ap, bv, ya[et]);
      }
    }
#pragma unroll
    for (int i = 0; i < 4; ++i) {
      const int row = row0 + wave * 16 + (lane >> 4) * 4 + i;
      float s = 0.f;
#pragma unroll
      for (int et = 0; et < 8; ++et) {
        const int e = et * 16 + (lane & 15);
        ya[et][i] += (float)yint[((size_t)0 * NT + row) * RETW + h * RET_HD + e] + (float)yint[((size_t)1 * NT + row) * RETW + h * RET_HD + e];
        s += ya[et][i];
      }
      s = row_sum16(s);
      const float mu = s * (1.f / 128.f);
      float s2 = 0.f;
#pragma unroll
      for (int et = 0; et < 8; ++et) { const float d_ = ya[et][i] - mu; s2 += d_ * d_; }
      s2 = row_sum16(s2);
      const float rstd = rsqrtf(s2 * (1.f / 128.f) + RET_EPS);
#pragma unroll
      for (int et = 0; et < 8; ++et) {
        const int e = et * 16 + (lane & 15);
        const float g = (float)p[(size_t)row * NP_EV + 3 * HY_CH + 3 * RETW + h * RET_HD + e];
        mix[(size_t)row * D + HY_CH + h * RET_HD + e] = (h16)((ya[et][i] - mu) * rstd * siluf_(g));
      }
    }
  }
}

constexpr int LN_VW = (D >= 256) ? 4 : (D / 64);
constexpr int LN_NCH = D / (64 * LN_VW);
template <bool IN16, bool OUT16>
__device__ __forceinline__ void ph_ln1(const Params& P, int layer, const float* xlat, const float* xctx, float* olat, float* octx, const h16* Y, int nrows, char* smem) {
  (void)smem;
  h16* xq = (h16*)(P.ws + O_ABUF);
  const float* g = P.ln_g + (size_t)(layer * 2 + 0) * D;
  const float* bb = P.ln_b + (size_t)(layer * 2 + 0) * D;
  const int tid = TIDX, wave = tid >> 6, lane = tid & 63;
  for (int row = blockIdx.x * (NTHR / 64) + wave; row < nrows; row += gridDim.x * (NTHR / 64)) {
    const float* xs = (row < NL ? xlat + (size_t)row * D : xctx + (size_t)(row - NL) * D) + lane * LN_VW;
    float* xo = (row < NL ? olat + (size_t)row * D : octx + (size_t)(row - NL) * D) + lane * LN_VW;
    const h16* yp = Y + (size_t)row * D + lane * LN_VW;
    const float* gt = mod_ptr(P, layer, row, 2) + lane * LN_VW;
    const float* sh2 = mod_ptr(P, layer, row, 3) + lane * LN_VW;
    const float* sc2 = mod_ptr(P, layer, row, 4) + lane * LN_VW;
    float4 v[LN_NCH];
    float s = 0.f;
#pragma unroll
    for (int c = 0; c < LN_NCH; ++c) {
      float4 xa; const float4 ga = *(const float4*)(gt + c * 64 * LN_VW);
      if (IN16 && row < NL) { const h16x4 xh_ = *(const h16x4*)((const h16*)(xlat + (size_t)row * D) + lane * LN_VW + c * 64 * LN_VW); xa = make_float4((float)xh_[0], (float)xh_[1], (float)xh_[2], (float)xh_[3]); }
      else xa = *(const float4*)(xs + c * 64 * LN_VW);
      const h16x4 yh = *(const h16x4*)(yp + c * 64 * LN_VW);
      const float4 ya = make_float4((float)yh[0], (float)yh[1], (float)yh[2], (float)yh[3]);
      v[c].x = ALPHA * xa.x + ga.x * ya.x; v[c].y = ALPHA * xa.y + ga.y * ya.y; v[c].z = ALPHA * xa.z + ga.z * ya.z; v[c].w = ALPHA * xa.w + ga.w * ya.w;
      s += (v[c].x + v[c].y) + (v[c].z + v[c].w);
    }
    s = wave_sum(s);
    const float mu = s / (float)D;
    float s2 = 0.f;
#pragma unroll
    for (int c = 0; c < LN_NCH; ++c) {
      const float a = v[c].x - mu, b2 = v[c].y - mu, c2 = v[c].z - mu, d2 = v[c].w - mu;
      s2 += (a * a + b2 * b2) + (c2 * c2 + d2 * d2);
    }
    s2 = wave_sum(s2);
    const float rstd = rsqrtf(s2 / (float)D + LN_EPS);
#pragma unroll
    for (int c = 0; c < LN_NCH; ++c) {
      const int off = c * 64 * LN_VW;
      const float4 gv = *(const float4*)(g + lane * LN_VW + off), bv = *(const float4*)(bb + lane * LN_VW + off);
      const float4 sv = *(const float4*)(sc2 + off), hv = *(const float4*)(sh2 + off);
      float4 o;
      o.x = (v[c].x - mu) * rstd * gv.x + bv.x; o.y = (v[c].y - mu) * rstd * gv.y + bv.y;
      o.z = (v[c].z - mu) * rstd * gv.z + bv.z; o.w = (v[c].w - mu) * rstd * gv.w + bv.w;
      if (OUT16 && row < NL) { h16x4 oh_; oh_[0] = (h16)o.x; oh_[1] = (h16)o.y; oh_[2] = (h16)o.z; oh_[3] = (h16)o.w; *(h16x4*)((h16*)(olat + (size_t)row * D) + lane * LN_VW + off) = oh_; }
      else *(float4*)(xo + off) = o;
      h16x4 q;
      q[0] = (h16)(o.x * (1.f + sv.x) + hv.x); q[1] = (h16)(o.y * (1.f + sv.y) + hv.y);
      q[2] = (h16)(o.z * (1.f + sv.z) + hv.z); q[3] = (h16)(o.w * (1.f + sv.w) + hv.w);
      *(h16x4*)(xq + (size_t)row * D + lane * LN_VW + off) = q;
    }
  }
}
static_assert(D % NTHR == 0 || D < NTHR, "D vs block");

constexpr int SC_LD = PEER_KEYS + 4;
constexpr int SEL_QN = PEER_KEYS / 4;
static_assert(PEER_KEYS <= 128 && 64 * 264 * 2 <= 40960, "select LDS plan / 7-bit index");
__device__ __forceinline__ int cand_count(int a) { return (int)((0x1112347FULL >> (4 * a)) & 15ULL) + 1; }
__device__ __forceinline__ void ph_peer_select(const Params& P, int layer, const h16* Q, int nrows, char* smem) {
  constexpr int QLD = 264;
  float* sc = (float*)smem;
  char* r1 = (char*)(sc + 128 * SC_LD);
  h16* qs = (h16*)r1;
  unsigned* tqk = (unsigned*)r1;
  float* cd = (float*)r1;
  float* tv = cd + 64 * 52;
  int* tp = (int*)(tv + 64 * 16);
  float* ts = (float*)(r1 + 40960);
  unsigned char* ti = (unsigned char*)(ts + 16 * 128);
  int* cab = (int*)(ti + 16 * 128);
  const h16* keys = (const h16*)(P.ws + O_KEYS16);
  int* seli = (int*)(P.ws + O_SELI);
  float* selg = (float*)(P.ws + O_SELG);
  const int ntile = nrows / 64;
  (void)layer;
  const int tid = TIDX, wave = tid >> 6, lane = tid & 63;
  if (tid == 0) { int nc = 0; for (int a = 0; a < 16; ++a) for (int b = 0; b < cand_count(a); ++b) cab[nc++] = a * 16 + b; }
  for (int u = blockIdx.x; u < ntile * PEER_H; u += gridDim.x) {
    const int hh = u % PEER_H, tile = u / PEER_H, row0 = tile * 64;
    __syncthreads();
#pragma unroll 4
    for (int i = tid; i < 64 * 32; i += NTHR) {
      const int r = i / 32, c8 = i % 32;
      *(h16x8*)(qs + r * QLD + c8 * 8) = *(const h16x8*)(Q + (size_t)(row0 + r) * QW + hh * PEER_QD + c8 * 8);
    }
    __syncthreads();
    for (int pr = wave; pr < 2 * (PEER_KEYS / 16); pr += NTHR / 64) {
      const int p = pr / (PEER_KEYS / 16), ntl = pr % (PEER_KEYS / 16);
      h16x8 bf[4];
#pragma unroll
      for (int ks = 0; ks < 4; ++ks) bf[ks] = *(const h16x8*)(keys + ((size_t)(hh * 2 + p) * PEER_KEYS + ntl * 16 + (lane & 15)) * 128 + ks * 32 + (lane >> 4) * 8);
      f32x4 acc[4];
#pragma unroll
      for (int mt = 0; mt < 4; ++mt) acc[mt] = (f32x4){0.f, 0.f, 0.f, 0.f};
#pragma unroll
      for (int ks = 0; ks < 4; ++ks)
#pragma unroll
        for (int mt = 0; mt < 4; ++mt) {
          const h16x8 af = *(const h16x8*)(qs + (mt * 16 + (lane & 15)) * QLD + p * 128 + ks * 32 + (lane >> 4) * 8);
          acc[mt] = MFMA16(af, bf[ks], acc[mt]);
        }
#pragma unroll
      for (int mt = 0; mt < 4; ++mt)
#pragma unroll
        for (int i = 0; i < 4; ++i) sc[((mt * 16 + (lane >> 4) * 4 + i) * 2 + p) * SC_LD + ntl * 16 + (lane & 15)] = acc[mt][i];
    }
    __syncthreads();
    {
      const int qt = tid >> 7, list = tid & 127;
      const float* l = sc + list * SC_LD + qt * SEL_QN;
      unsigned key[SEL_QN];
#pragma unroll
      for (int n4 = 0; n4 < SEL_QN / 4; ++n4) {
        const float4 v = *(const float4*)(l + n4 * 4);
        const float vv[4] = {v.x, v.y, v.z, v.w};
#pragma unroll
        for (int e = 0; e < 4; ++e) {
          unsigned ub = __builtin_bit_cast(unsigned, vv[e]);
          ub = (ub & 0x80000000u) ? ~ub : (ub | 0x80000000u);
          key[n4 * 4 + e] = (ub & ~127u) | (unsigned)(127 - (qt * SEL_QN + n4 * 4 + e));
        }
      }
#pragma unroll
      for (int size = 2; size <= SEL_QN; size *= 2)
#pragma unroll
        for (int stride = size / 2; stride > 0; stride /= 2)
#pragma unroll
          for (int i = 0; i < SEL_QN; ++i) {
            const int j = i ^ stride;
            if (j > i) {
              const unsigned a_ = key[i], b_ = key[j];
              const bool desc = (i & size) == 0;
              const unsigned hi = a_ > b_ ? a_ : b_, lo = a_ > b_ ? b_ : a_;
              key[i] = desc ? hi : lo; key[j] = desc ? lo : hi;
            }
          }
#pragma unroll
      for (int k = 0; k < TOPK; ++k) tqk[(qt * 16 + k) * 128 + list] = k < SEL_QN ? key[k] : 0u;
    }
    __syncthreads();
#pragma unroll 1
    for (int round = 0; round < 2; ++round) {
      const int qt = tid >> 7, list = tid & 127;
      const bool active = round == 0 ? (qt == 0 || qt == 2) : (qt == 0);
      const int qa = qt, qb = round == 0 ? qt + 1 : 2;
      if (active) {
        unsigned c[TOPK];
#pragma unroll
        for (int k = 0; k < TOPK; ++k) {
          const unsigned a_ = tqk[(qa * 16 + k) * 128 + list], b_ = tqk[(qb * 16 + (TOPK - 1 - k)) * 128 + list];
          c[k] = a_ > b_ ? a_ : b_;
        }
#pragma unroll
        for (int stride = TOPK / 2; stride > 0; stride /= 2)
#pragma unroll
          for (int i = 0; i < TOPK; ++i) {
            const int j = i ^ stride;
            if (j > i) { const unsigned a_ = c[i], b_ = c[j]; c[i] = a_ > b_ ? a_ : b_; c[j] = a_ > b_ ? b_ : a_; }
          }
        if (round == 0) {
#pragma unroll
          for (int k = 0; k < TOPK; ++k) tqk[(qa * 16 + k) * 128 + list] = c[k];
        } else {
#pragma unroll
          for (int k = 0; k < TOPK; ++k) {
            const int idx = 127 - (int)(c[k] & 127u);
            ts[k * 128 + list] = sc[list * SC_LD + idx]; ti[k * 128 + list] = (unsigned char)idx;
          }
        }
      }
      __syncthreads();
    }
    for (int i = tid; i < 64 * 50; i += NTHR) {
      const int tok = i / 50, c = i % 50, ab = cab[c];
      cd[tok * 52 + c] = ts[(ab >> 4) * 128 + tok * 2] + ts[(ab & 15) * 128 + tok * 2 + 1];
    }
    __syncthreads();
    for (int i = tid; i < 64 * 50; i += NTHR) {
      const int tok = i / 50, c = i % 50;
      const float v = cd[tok * 52 + c];
      int rank = 0;
      for (int j = 0; j < 50; ++j) { const float o = cd[tok * 52 + j]; rank += (o > v || (o == v && j < c)) ? 1 : 0; }
      if (rank < TOPK) { tv[tok * 16 + rank] = v; tp[tok * 16 + rank] = c; }
    }
    __syncthreads();
    for (int i = tid; i < 64 * 16; i += NTHR) {
      const int tok = i / 16, k = i % 16;
      const float mx = tv[tok * 16];
      float den = 0.f;
#pragma unroll
      for (int j = 0; j < TOPK; ++j) den += __expf(tv[tok * 16 + j] - mx);
      const int ab = cab[tp[tok * 16 + k]];
      const int row = row0 + tok;
      seli[(size_t)row * NSEL + hh * TOPK + k] = (int)ti[(ab >> 4) * 128 + tok * 2] * PEER_KEYS + (int)ti[(ab & 15) * 128 + tok * 2 + 1];
      selg[(size_t)row * NSEL + hh * TOPK + k] = __expf(tv[tok * 16 + k] - mx) / den;
    }
  }
}

constexpr int PB_G = 4;
struct P6Blk { unsigned w[6]; unsigned sb; };
#ifdef EMU
#define READLANE_I(v, l) __shfl((int)(v), (l))
#define READLANE_F(v, l) __shfl((float)(v), (l))
#else
#define READLANE_I(v, l) __builtin_amdgcn_readlane((int)(v), (l))
#define READLANE_F(v, l) __builtin_bit_cast(float, __builtin_amdgcn_readlane(__builtin_bit_cast(int, (float)(v)), (l)))
#endif
__device__ __forceinline__ void ph_peer_apply(const Params& P, int layer, float* xlat, float* xctx_in, float* xctx_out, int nrows, bool write_next, char* smem, float* xlat_out = nullptr) {
  (void)smem;
  h16* xq = (h16*)(P.ws + O_ABUF);
  const unsigned char* tu = (const unsigned char*)(P.ws + O_TABU);
  const unsigned char* tv = (const unsigned char*)(P.ws + O_TABV);
  const int* seli = (const int*)(P.ws + O_SELI);
  const float* selg = (const float*)(P.ws + O_SELG);
  const float* g = P.ln_g + (size_t)(layer * 2 + 1) * D;
  const float* bb = P.ln_b + (size_t)(layer * 2 + 1) * D;
  const int tid = TIDX, wave = tid >> 6, lane = tid & 63;
  const bool lact = lane < P6_NB;
  const int lb = lact ? lane : 0;
  for (int row = blockIdx.x * (NTHR / 64) + wave; row < nrows; row += gridDim.x * (NTHR / 64)) {
    float xv[32];
#pragma unroll
    for (int j8 = 0; j8 < 4; ++j8) {
      const h16x8 t = *(const h16x8*)(xq + (size_t)row * D + lb * 32 + j8 * 8);
#pragma unroll
      for (int j = 0; j < 8; ++j) xv[j8 * 8 + j] = lact ? (float)t[j] : 0.f;
    }
    const int id0 = seli[(size_t)row * NSEL + lane], id1 = seli[(size_t)row * NSEL + 64 + lane];
    const float g0 = selg[(size_t)row * NSEL + lane], g1 = selg[(size_t)row * NSEL + 64 + lane];
    float a0 = 0.f, a1 = 0.f;
    P6Blk bufA[PB_G], bufB[PB_G];
#define PB_LOAD(buf, tab, grp) do { _Pragma("unroll") for (int k_ = 0; k_ < PB_G; ++k_) { const int e_ = (grp) * PB_G + k_; \
      const int id_ = READLANE_I(e_ < 64 ? id0 : id1, e_ & 63); const unsigned char* rp_ = (tab) + (size_t)id_ * P6_ROWB; \
      const unsigned* wp_ = (const unsigned*)(rp_ + lb * 24); \
      _Pragma("unroll") for (int q_ = 0; q_ < 6; ++q_) buf[k_].w[q_] = wp_[q_]; \
      buf[k_].sb = rp_[P6_NB * 24 + lb]; } } while (0)
#ifdef EMU
#define PB_FENCE
#else
#define PB_FENCE asm volatile("" ::: "memory")
#endif
#define PB_DOT(buf, grp) do { _Pragma("unroll") for (int k_ = 0; k_ < PB_G; ++k_) { const int e_ = (grp) * PB_G + k_; \
      float f_[32]; p6_decode32((u32x6){buf[k_].w[0], buf[k_].w[1], buf[k_].w[2], buf[k_].w[3], buf[k_].w[4], buf[k_].w[5]}, p6_scale_from_byte(buf[k_].sb), f_); \
      float acc_ = 0.f, acc2_ = 0.f; \
      _Pragma("unroll") for (int j_ = 0; j_ < 32; j_ += 2) { acc_ += xv[j_] * f_[j_]; acc2_ += xv[j_ + 1] * f_[j_ + 1]; } \
      acc_ = wave_sum(acc_ + acc2_); if (e_ < 64) { if (lane == e_) a0 = acc_; } else { if (lane == e_ - 64) a1 = acc_; } } } while (0)
    constexpr int NG = NSEL / PB_G;
    PB_LOAD(bufA, tu, 0);
    for (int gq = 0; gq < NG; gq += 2) {
      PB_LOAD(bufB, tu, gq + 1); PB_FENCE;
      PB_DOT(bufA, gq);
      if (gq + 2 < NG) PB_LOAD(bufA, tu, gq + 2);
      PB_FENCE;
      PB_DOT(bufB, gq + 1);
    }
    a0 = geluf_(a0) * g0; a1 = geluf_(a1) * g1;
    float o[32];
#pragma unroll
    for (int j = 0; j < 32; ++j) o[j] = 0.f;
#define PB_ACC(buf, grp) do { _Pragma("unroll") for (int k_ = 0; k_ < PB_G; ++k_) { const int e_ = (grp) * PB_G + k_; \
      const float a_ = READLANE_F(e_ < 64 ? a0 : a1, e_ & 63); \
      float f_[32]; p6_decode32((u32x6){buf[k_].w[0], buf[k_].w[1], buf[k_].w[2], buf[k_].w[3], buf[k_].w[4], buf[k_].w[5]}, p6_scale_from_byte(buf[k_].sb), f_); \
      _Pragma("unroll") for (int j_ = 0; j_ < 32; ++j_) o[j_] += a_ * f_[j_]; } } while (0)
    PB_LOAD(bufA, tv, 0);
    for (int gq = 0; gq < NG; gq += 2) {
      PB_LOAD(bufB, tv, gq + 1); PB_FENCE;
      PB_ACC(bufA, gq);
      if (gq + 2 < NG) PB_LOAD(bufA, tv, gq + 2);
      PB_FENCE;
      PB_ACC(bufB, gq + 1);
    }
#undef PB_LOAD
#undef PB_DOT
#undef PB_ACC
    const float* xs1 = (row < NL ? xlat + (size_t)row * D : xctx_in + (size_t)(row - NL) * D) + lb * 32;
    float* xo = (row < NL ? (xlat_out ? xlat_out : xlat) + (size_t)row * D : xctx_out + (size_t)(row - NL) * D) + lb * 32;
    const float* gt = mod_ptr(P, layer, row, 5) + lb * 32;
    float s = 0.f;
#pragma unroll
    for (int j4 = 0; j4 < 8; ++j4) {
      float4 xa; const float4 ga = *(const float4*)(gt + j4 * 4);
      if (row < NL) { const h16x4 xh_ = *(const h16x4*)((const h16*)(xlat + (size_t)row * D) + lb * 32 + j4 * 4); xa = make_float4((float)xh_[0], (float)xh_[1], (float)xh_[2], (float)xh_[3]); }
      else xa = *(const float4*)(xs1 + j4 * 4);
      o[j4 * 4 + 0] = ALPHA * xa.x + ga.x * o[j4 * 4 + 0]; o[j4 * 4 + 1] = ALPHA * xa.y + ga.y * o[j4 * 4 + 1];
      o[j4 * 4 + 2] = ALPHA * xa.z + ga.z * o[j4 * 4 + 2]; o[j4 * 4 + 3] = ALPHA * xa.w + ga.w * o[j4 * 4 + 3];
      s += (o[j4 * 4 + 0] + o[j4 * 4 + 1]) + (o[j4 * 4 + 2] + o[j4 * 4 + 3]);
    }
    s = wave_sum(lact ? s : 0.f);
    const float mu = s / (float)D;
    float s2 = 0.f;
#pragma unroll
    for (int j = 0; j < 32; ++j) { const float dd = o[j] - mu; s2 += dd * dd; }
    s2 = wave_sum(lact ? s2 : 0.f);
    const float rstd = rsqrtf(s2 / (float)D + LN_EPS);
    const float* gp = g + lb * 32; const float* bp = bb + lb * 32;
    const float* sh1n = mod_ptr(P, 1, row, 0) + lb * 32;
    const float* sc1n = mod_ptr(P, 1, row, 1) + lb * 32;
    if (lact) {
#pragma unroll
      for (int j4 = 0; j4 < 8; ++j4) {
        const float4 gv = *(const float4*)(gp + j4 * 4), bv = *(const float4*)(bp + j4 * 4);
        float4 ov;
        ov.x = (o[j4 * 4 + 0] - mu) * rstd * gv.x + bv.x; ov.y = (o[j4 * 4 + 1] - mu) * rstd * gv.y + bv.y;
        ov.z = (o[j4 * 4 + 2] - mu) * rstd * gv.z + bv.z; ov.w = (o[j4 * 4 + 3] - mu) * rstd * gv.w + bv.w;
        if (row < NL && write_next) { h16x4 oh_; oh_[0] = (h16)ov.x; oh_[1] = (h16)ov.y; oh_[2] = (h16)ov.z; oh_[3] = (h16)ov.w; *(h16x4*)((h16*)((xlat_out ? xlat_out : xlat) + (size_t)row * D) + lb * 32 + j4 * 4) = oh_; }
        else *(float4*)(xo + j4 * 4) = ov;
        if (write_next) {
          const float4 sv = *(const float4*)(sc1n + j4 * 4), hv = *(const float4*)(sh1n + j4 * 4);
          h16x4 nx;
          nx[0] = (h16)(ov.x * (1.f + sv.x) + hv.x); nx[1] = (h16)(ov.y * (1.f + sv.y) + hv.y);
          nx[2] = (h16)(ov.z * (1.f + sv.z) + hv.z); nx[3] = (h16)(ov.w * (1.f + sv.w) + hv.w);
          *(h16x4*)(xq + (size_t)row * D + lb * 32 + j4 * 4) = nx;
        }
      }
    }
  }
}

__device__ __forceinline__ void lru_chunk_info(int b, int n, int& rbase, int& L, int& t0) {
  if (n < LRU_LCH) { rbase = b * SEQ; L = SEQ; t0 = n * LRU_T; }
  else { rbase = NL + b * CTX_LEN; L = CTX_LEN; t0 = (n - LRU_LCH) * LRU_T; }
}
__device__ __forceinline__ int lru_order(int n, int dir) {
  if (n >= LRU_LCH) { int c = n - LRU_LCH; return dir == 0 ? c : LRU_CCH - 1 - c; }
  return LRU_CCH + (dir == 0 ? n : LRU_LCH - 1 - n);
}
__device__ __forceinline__ void lru_coeffs(const Params& P, int b, int n, int blk, float* xcs, float* as_, float* bs_, h16* xh) {
  const h16* pl = (const h16*)(P.ws + O_PLRU);
  const h16* lw = (const h16*)(P.ws + O_LW16);
  h16* cfa = (h16*)(P.ws + O_FEAT);
  h16* cfb = cfa + (size_t)2 * NL * LRUW;
  int rbase, L, t0; lru_chunk_info(b, n, rbase, L, t0);
  const int ch0 = blk * LRU_BD;
  const int tid = TIDX, wave = tid >> 6, lane = tid & 63;
  __syncthreads();
  {
    const int t = tid / 8, c8 = (tid % 8) * 8, chb = ch0 + c8;
    const float4 b0 = *(const float4*)(P.lru_conv_b + chb), b1 = *(const float4*)(P.lru_conv_b + chb + 4);
    float acc[8] = {b0.x, b0.y, b0.z, b0.w, b1.x, b1.y, b1.z, b1.w};
#pragma unroll
    for (int k = 0; k < 4; ++k) {
      const int tt = t0 + t + k - 1;
      if (tt >= 0 && tt < L) {
        const h16x8 pv = *(const h16x8*)(pl + (size_t)(rbase + tt) * (2 * LRUW) + chb);
        const float4 w0 = *(const float4*)(P.lru_conv_w + k * LRUW + chb), w1 = *(const float4*)(P.lru_conv_w + k * LRUW + chb + 4);
        acc[0] += w0.x * (float)pv[0]; acc[1] += w0.y * (float)pv[1]; acc[2] += w0.z * (float)pv[2]; acc[3] += w0.w * (float)pv[3];
        acc[4] += w1.x * (float)pv[4]; acc[5] += w1.y * (float)pv[5]; acc[6] += w1.z * (float)pv[6]; acc[7] += w1.w * (float)pv[7];
      }
    }
    h16x8 xv;
#pragma unroll
    for (int j = 0; j < 8; ++j) { xcs[t * 65 + c8 + j] = acc[j]; xv[j] = (h16)acc[j]; }
    *(h16x8*)(xh + t * 72 + c8) = xv;
  }
  __syncthreads();
  const int d = wave >> 2, nt = wave & 3;
  const int j = nt * 16 + (lane & 15), ch = ch0 + j;
  f32x4 accr[4], acci[4];
#pragma unroll
  for (int mt = 0; mt < 4; ++mt) { accr[mt] = (f32x4){0.f, 0.f, 0.f, 0.f}; acci[mt] = (f32x4){0.f, 0.f, 0.f, 0.f}; }
  const h16* wr = lw + (((size_t)(d * LRU_BLOCKS + blk) * 2 + 0) * 64 + j) * 64 + (lane >> 4) * 8;
  const h16* wi = wr + 64 * 64;
#pragma unroll
  for (int ks = 0; ks < 2; ++ks) {
    const h16x8 br = *(const h16x8*)(wr + ks * 32), bi = *(const h16x8*)(wi + ks * 32);
#pragma unroll
    for (int mt = 0; mt < 4; ++mt) {
      const h16x8 af = *(const h16x8*)(xh + (mt * 16 + (lane & 15)) * 72 + ks * 32 + (lane >> 4) * 8);
      accr[mt] = MFMA16(af, br, accr[mt]);
      acci[mt] = MFMA16(af, bi, acci[mt]);
    }
  }
  const float ba = P.lru_ba[d * LRUW + ch], bx = P.lru_bx[d * LRUW + ch];
  const float sp8 = -8.0f * softplusf_(-P.lru_lam[d * LRUW + ch]);
  const bool islat = n < LRU_LCH;
#pragma unroll
  for (int mt = 0; mt < 4; ++mt)
#pragma unroll
    for (int i = 0; i < 4; ++i) {
      const int t = mt * 16 + (lane >> 4) * 4 + i;
      const float r = 1.f / (1.f + __expf(-(accr[mt][i] + ba)));
      const float ig = 1.f / (1.f + __expf(-(acci[mt][i] + bx)));
      const float log_a = sp8 * r;
      const float a = __expf(log_a);
      const float bq = sqrtf(fmaxf(1.f - a * a, 0.f)) * (ig * xcs[t * 65 + j]);
      as_[(d * 64 + t) * 65 + j] = a;
      bs_[(d * 64 + t) * 65 + j] = bq;
      if (islat) {
        const size_t o = ((size_t)d * NL + rbase + t0 + t) * LRUW + ch;
        cfa[o] = (h16)log_a; cfb[o] = (h16)bq;
      }
    }
  __syncthreads();
}
__device__ __forceinline__ void ph_lru_a(const Params& P, char* smem) {
  float* xcs = (float*)smem; float* as_ = xcs + 64 * 65; float* bs_ = as_ + 2 * 64 * 65; h16* xh = (h16*)(bs_ + 2 * 64 * 65);
  float2* lsum = (float2*)(P.ws + O_LSUM);
  constexpr int NU = BATCH * LRU_NCH * LRU_BLOCKS;
  for (int u = blockIdx.x; u < NU; u += gridDim.x) {
    const int blk = u % LRU_BLOCKS, n = (u / LRU_BLOCKS) % LRU_NCH, b = u / (LRU_BLOCKS * LRU_NCH);
    lru_coeffs(P, b, n, blk, xcs, as_, bs_, xh);
    const int tid = TIDX;
    if (tid < 128) {
      const int d = tid / 64, j = tid % 64;
      float A = 1.f, Bv = 0.f;
      for (int s = 0; s < 64; ++s) {
        const int t = d == 0 ? s : 63 - s;
        const float a = as_[(d * 64 + t) * 65 + j];
        Bv = a * Bv + bs_[(d * 64 + t) * 65 + j];
        A *= a;
      }
      lsum[(((size_t)d * BATCH + b) * LRU_NCH + lru_order(n, d)) * LRUW + blk * 64 + j] = make_float2(A, Bv);
    }
  }
}
__device__ __forceinline__ void ph_lru_b(const Params& P) {
  const float2* lsum = (const float2*)(P.ws + O_LSUM);
  float* lcar = (float*)(P.ws + O_LCAR);
  const int total = 2 * BATCH * LRUW;
  static_assert(LRU_NCH % 4 == 0, "lru carry unroll");
  for (int i = blockIdx.x * NTHR + TIDX; i < total; i += gridDim.x * NTHR) {
    const int ch = i % LRUW, db = i / LRUW;
    float h = 0.f;
    for (int o = 0; o < LRU_NCH; o += 4) {
      const size_t off = ((size_t)db * LRU_NCH + o) * LRUW + ch;
      const float2 s0 = lsum[off], s1 = lsum[off + LRUW], s2 = lsum[off + 2 * LRUW], s3 = lsum[off + 3 * LRUW];
      lcar[off] = h; h = s0.x * h + s0.y;
      lcar[off + LRUW] = h; h = s1.x * h + s1.y;
      lcar[off + 2 * LRUW] = h; h = s2.x * h + s2.y;
      lcar[off + 3 * LRUW] = h; h = s3.x * h + s3.y;
    }
  }
}
__device__ __forceinline__ void ph_lru_c(const Params& P, char* smem) {
  float* as_ = (float*)smem; float* bs_ = as_ + 2 * 64 * 65;
  const float* lcar = (const float*)(P.ws + O_LCAR);
  const h16* pl = (const h16*)(P.ws + O_PLRU);
  const h16* cfa = (const h16*)(P.ws + O_FEAT);
  const h16* cfb = cfa + (size_t)2 * NL * LRUW;
  h16* mixl = (h16*)(P.ws + O_MIXLRU);
  constexpr int NU = BATCH * LRU_LCH * LRU_BLOCKS;
  for (int u = blockIdx.x; u < NU; u += gridDim.x) {
    const int blk = u % LRU_BLOCKS, n = (u / LRU_BLOCKS) % LRU_LCH, b = u / (LRU_BLOCKS * LRU_LCH);
    const int row0 = b * SEQ + n * LRU_T;
    const int tid = TIDX;
    __syncthreads();
#pragma unroll 4
    for (int i = tid; i < 2 * 64 * 16; i += NTHR) {
      const int c4 = i % 16, t = (i / 16) % 64, d = i / 1024;
      const size_t o = ((size_t)d * NL + row0 + t) * LRUW + blk * 64 + c4 * 4;
      const h16x4 la = *(const h16x4*)(cfa + o), bq = *(const h16x4*)(cfb + o);
#pragma unroll
      for (int q = 0; q < 4; ++q) { as_[(d * 64 + t) * 65 + c4 * 4 + q] = __expf((float)la[q]); bs_[(d * 64 + t) * 65 + c4 * 4 + q] = (float)bq[q]; }
    }
    __syncthreads();
    if (tid < 128) {
      const int d = tid / 64, j = tid % 64;
      float h = lcar[(((size_t)d * BATCH + b) * LRU_NCH + lru_order(n, d)) * LRUW + blk * 64 + j];
      for (int s = 0; s < 64; ++s) {
        const int t = d == 0 ? s : 63 - s;
        h = as_[(d * 64 + t) * 65 + j] * h + bs_[(d * 64 + t) * 65 + j];
        bs_[(d * 64 + t) * 65 + j] = h;
      }
    }
    __syncthreads();
#pragma unroll 2
    for (int i = tid; i < 64 * 16; i += NTHR) {
      const int t = i / 16, c4 = i % 16, ch = blk * 64 + c4 * 4;
      const h16x4 gate = *(const h16x4*)(pl + (size_t)(row0 + t) * (2 * LRUW) + LRUW + ch);
      h16x4 ov;
#pragma unroll
      for (int q = 0; q < 4; ++q) {
        const float y = bs_[(0 * 64 + t) * 65 + c4 * 4 + q] + bs_[(1 * 64 + t) * 65 + c4 * 4 + q];
        ov[q] = (h16)(y * geluf_((float)gate[q]));
      }
      *(h16x4*)(mixl + (size_t)(row0 + t) * LRUW + ch) = ov;
    }
  }
}

struct RwFeat { h16 *rec0, *sh, *v; h16* gls; float* bonus;
  __device__ __forceinline__ h16* rec(int d) const { return rec0 + (size_t)d * 3 * NT * RWW; } };
__device__ __forceinline__ RwFeat rw_feat(const Params& P) {
  RwFeat f;
  f.rec0 = (h16*)(P.ws + O_PLRU);
  f.v = f.rec0 + (size_t)6 * NT * RWW;
  f.sh = (h16*)(P.ws + O_ABUF);
  f.gls = (h16*)(P.ws + O_GLS); f.bonus = (float*)(P.ws + O_BONUS);
  return f;
}
static_assert(O_FEAT == O_PLRU + (size_t)NT * 2 * LRUW * 2 && LRUW == RWW, "rwkv records span P_lru + FEAT");
__device__ __forceinline__ void rw_shifted8(const Params& P, const h16* prw, int row, int col0, float* out) {
  int isc, b, t; row_decode(row, isc, b, t);
  const h16* pr = prw + (size_t)row * RW_SHIFT + col0;
  const h16x8 pv = *(const h16x8*)pr;
  const h16x8 z8 = (h16x8){0, 0, 0, 0, 0, 0, 0, 0};
  h16x8 n0 = z8, n1 = z8, n2 = z8, n3 = z8;
  if (!isc) {
    const int gr = t / GRID_W, gc = t % GRID_W;
    if (gc > 0) n0 = *(const h16x8*)(pr - RW_SHIFT);
    if (gc < GRID_W - 1) n1 = *(const h16x8*)(pr + RW_SHIFT);
    if (gr > 0) n2 = *(const h16x8*)(pr - (size_t)GRID_W * RW_SHIFT);
    if (gr < GRID_ROWS - 1) n3 = *(const h16x8*)(pr + (size_t)GRID_W * RW_SHIFT);
  } else {
    if (t > 0) n0 = *(const h16x8*)(pr - RW_SHIFT);
    if (t < CTX_LEN - 1) n1 = *(const h16x8*)(pr + RW_SHIFT);
    n2 = n0; n3 = n1;
  }
  const float4 m0 = *(const float4*)(P.rw_mu + col0), m1 = *(const float4*)(P.rw_mu + col0 + 4);
  const float mu[8] = {m0.x, m0.y, m0.z, m0.w, m1.x, m1.y, m1.z, m1.w};
#pragma unroll
  for (int j = 0; j < 8; ++j) {
    const float pvj = (float)pv[j];
    const float nb = (j & 3) == 0 ? (float)n0[j] : (j & 3) == 1 ? (float)n1[j] : (j & 3) == 2 ? (float)n2[j] : (float)n3[j];
    out[j] = pvj + (nb - pvj) * mu[j];
  }
}
__device__ __forceinline__ float sum8(float v) {
#ifdef EMU
  v += __shfl_xor(v, 1); v += __shfl_xor(v, 2); v += __shfl_xor(v, 4);
#else
  v += dppf<0xB1>(v); v += dppf<0x4E>(v); v += dppf<0x141>(v);
#endif
  return v;
}
__device__ __forceinline__ void ph_rw_feat(const Params& P, char* smem) {
  constexpr int LDK = RWW + 8;
  h16* lwh = (h16*)smem;
  h16* lah = lwh + 16 * 72;
  h16* ks = lah + 16 * 72;
  h16* kks = ks + 16 * LDK;
  h16* rs = kks + 16 * LDK;
  float* bon = (float*)(rs + 16 * LDK);
  const h16* prw = (const h16*)(P.ws + O_PRW);
  const h16* rw16 = (const h16*)(P.ws + O_RW16);
  RwFeat F = rw_feat(P);
  const int tid = TIDX, wave = tid >> 6, lane = tid & 63;
  for (int u = blockIdx.x; u < NT / 16; u += gridDim.x) {
    const int row0 = u * 16;
    __syncthreads();
    for (int i = tid; i < 16 * 16; i += NTHR) {
      const int tl = i / 16, g8 = i % 16;
      float v[8]; rw_shifted8(P, prw, row0 + tl, 3 * RWW + g8 * 8, v);
      h16x8 o;
      if (g8 < 8) {
#pragma unroll
        for (int j = 0; j < 8; ++j) o[j] = (h16)tanhf(v[j]);
        *(h16x8*)(lwh + tl * 72 + g8 * 8) = o;
      } else {
#pragma unroll
        for (int j = 0; j < 8; ++j) o[j] = (h16)v[j];
        *(h16x8*)(lah + tl * 72 + (g8 - 8) * 8) = o;
      }
    }
    for (int i = tid; i < 16 * 20; i += NTHR) {
      const int tl = i / 20, g8 = i % 20;
      float v[8]; rw_shifted8(P, prw, row0 + tl, 3 * RWW + 128 + g8 * 8, v);
      h16x8 o;
#pragma unroll
      for (int j = 0; j < 8; ++j) o[j] = (h16)v[j];
      *(h16x8*)(F.gls + (size_t)(row0 + tl) * 160 + g8 * 8) = o;
    }
    if (tid < 16 * RW_H) bon[tid] = 0.f;
#pragma unroll 2
    for (int it = tid; it < 16 * (RWW / 8); it += NTHR) {
      const int tl = it / (RWW / 8), j8 = (it % (RWW / 8)) * 8, row = row0 + tl;
      float r[8], kv[8], vv[8];
      rw_shifted8(P, prw, row, j8, r); rw_shifted8(P, prw, row, RWW + j8, kv); rw_shifted8(P, prw, row, 2 * RWW + j8, vv);
      const float4 k0 = *(const float4*)(P.rw_k_k + j8), k1 = *(const float4*)(P.rw_k_k + j8 + 4);
      const float kkw[8] = {k0.x, k0.y, k0.z, k0.w, k1.x, k1.y, k1.z, k1.w};
      float kr[8]; float n2 = 0.f;
#pragma unroll
      for (int j = 0; j < 8; ++j) { kr[j] = kv[j] * kkw[j]; n2 += kr[j] * kr[j]; }
      n2 = sum8(n2);
      const float rn = 1.f / fmaxf(sqrtf(n2), 1e-12f);
      h16x8 o_r, o_v, o_k, o_kk;
#pragma unroll
      for (int j = 0; j < 8; ++j) { o_r[j] = (h16)r[j]; o_v[j] = (h16)vv[j]; o_k[j] = (h16)kv[j]; o_kk[j] = (h16)(kr[j] * rn); }
      *(h16x8*)(F.v + (size_t)row * RWW + j8) = o_v;
      {
        h16* shp = F.sh + (size_t)row * RWW * 2 + (j8 / 4) * 8;
        h16x8 s0, s1;
#pragma unroll
        for (int j = 0; j < 4; ++j) { s0[j] = o_kk[j]; s0[4 + j] = o_r[j]; s1[j] = o_kk[4 + j]; s1[4 + j] = o_r[4 + j]; }
        *(h16x8*)shp = s0; *(h16x8*)(shp + 8) = s1;
      }
      *(h16x8*)(ks + tl * LDK + j8) = o_k; *(h16x8*)(kks + tl * LDK + j8) = o_kk; *(h16x8*)(rs + tl * LDK + j8) = o_r;
    }
    __syncthreads();
    h16x8 aw[2], aa[2];
#pragma unroll
    for (int kq = 0; kq < 2; ++kq) {
      aw[kq] = *(const h16x8*)(lwh + (lane & 15) * 72 + kq * 32 + (lane >> 4) * 8);
      aa[kq] = *(const h16x8*)(lah + (lane & 15) * 72 + kq * 32 + (lane >> 4) * 8);
    }
    for (int it = wave; it < 2 * (RWW / 16); it += NTHR / 64) {
      const int d = it / (RWW / 16), nt = it % (RWW / 16);
      const int n = nt * 16 + (lane & 15);
      const h16* bw = rw16 + (((size_t)(d * 2 + 0) * RWW + n) * 64) + (lane >> 4) * 8;
      const h16* ba = rw16 + (((size_t)(d * 2 + 1) * RWW + n) * 64) + (lane >> 4) * 8;
      f32x4 cw = (f32x4){0.f, 0.f, 0.f, 0.f}, ca = (f32x4){0.f, 0.f, 0.f, 0.f};
#pragma unroll
      for (int kq = 0; kq < 2; ++kq) {
        cw = MFMA16(aw[kq], *(const h16x8*)(bw + kq * 32), cw);
        ca = MFMA16(aa[kq], *(const h16x8*)(ba + kq * 32), ca);
      }
      const float w0 = P.rw_w0[d * RWW + n], a0 = P.rw_a0[d * RWW + n], ka = P.rw_k_a[n], rk = P.rw_r_k[n];
      h16* prec = F.rec(d) + (n / 4) * 12 + (n % 4);
#pragma unroll
      for (int i = 0; i < 4; ++i) {
        const int tl = (lane >> 4) * 4 + i, row = row0 + tl;
        const float xw = -(w0 + cw[i]);
        const float spl = xw > 20.f ? xw : __logf(1.f + __expf(xw));
        const float wn = __expf(-spl - 0.5f);
        const float om = wn < 0.01f ? wn * (1.f - 0.5f * wn * (1.f - wn * 0.33333334f)) : 1.f - __expf(-wn);
        const float a = 1.f / (1.f + __expf(-(a0 + ca[i])));
        const float kv = (float)ks[tl * LDK + n], kk = (float)kks[tl * LDK + n], r = (float)rs[tl * LDK + n];
        const float kd = kv * (1.f + (a - 1.f) * ka);
        prec[(size_t)row * RWW * 3] = (h16)(-om);
        prec[(size_t)row * RWW * 3 + 4] = (h16)kd;
        prec[(size_t)row * RWW * 3 + 8] = (h16)(-(kk * a));
        const float bsum = row_sum16(r * kd * rk);
        if ((lane & 15) == 0) atomicAdd(&bon[tl * RW_H + n / 64], bsum);
      }
    }
    __syncthreads();
    if (tid < 16 * RW_H) F.bonus[(size_t)(row0 + tid / RW_H) * RW_H + tid % RW_H] = bon[tid];
  }
}
static_assert(NT % 16 == 0, "rw feat units");

#ifdef EMU
__device__ __forceinline__ float fmix_lo(float a, unsigned pk, float c) { h16x2 h = __builtin_bit_cast(h16x2, pk); return a * (float)h[0] + c; }
__device__ __forceinline__ float fmix_hi(float a, unsigned pk, float c) { h16x2 h = __builtin_bit_cast(h16x2, pk); return a * (float)h[1] + c; }
#else
__device__ __forceinline__ float fmix_lo(float a, unsigned pk, float c) {
  float r; asm("v_fma_mix_f32 %0, %1, %2, %3 op_sel_hi:[0,1,0]" : "=v"(r) : "v"(a), "v"(pk), "v"(c)); return r; }
__device__ __forceinline__ float fmix_hi(float a, unsigned pk, float c) {
  float r; asm("v_fma_mix_f32 %0, %1, %2, %3 op_sel:[0,1,0] op_sel_hi:[0,1,0]" : "=v"(r) : "v"(a), "v"(pk), "v"(c)); return r; }
#endif
constexpr int RW_U = 8;
constexpr int RW_NS = CTX_LEN + SEQ;
static_assert(CTX_LEN % RW_U == 0 && SEQ % RW_U == 0, "scan blocks");
template <int VAR>
__device__ __forceinline__ void ph_rw_scan(const Params& P) {
  RwFeat F = rw_feat(P);
  h16* yout = (h16*)(P.ws + O_PRW);
#ifdef EMU
  const int tid = TIDX, wave = tid / 64, lane = tid % 64;
#else
  const int tid = TIDX, wave = __builtin_amdgcn_readfirstlane(tid / 64), lane = tid % 64;
#endif
  const int rl = lane / 16, q = lane % 16;
  constexpr int NWU = 2 * BATCH * RW_H * 16;
  for (int wu = blockIdx.x * 4 + wave; wave < 4 && wu < NWU; wu += gridDim.x * 4) {
    const int rg = wu % 16, hh = (wu / 16) % RW_H, b = (wu / (16 * RW_H)) % BATCH, dir = wu / (16 * RW_H * BATCH);
    const int vrow = rg * 4 + rl;
    const h16* p_rec = F.rec(dir); const h16* p_sh = F.sh; const h16* p_v = F.v;
    const unsigned g_ = (unsigned)(hh * 16 + q);
    const unsigned uvoff = (unsigned)(hh * 64 + vrow), urec = g_ * 12u, ush = g_ * 8u;
    h16x8 s_ok[RW_U], s_kr[RW_U]; h16x4 s_b[RW_U]; h16 s_v[RW_U];
    auto row_of = [&](int step) -> int {
      if (step < CTX_LEN) return NL + b * CTX_LEN + (dir == 0 ? step : CTX_LEN - 1 - step);
      const int s = step - CTX_LEN; return b * SEQ + (dir == 0 ? s : SEQ - 1 - s);
    };
#define RW_LOAD(slot, step) do { const size_t ro_ = (size_t)row_of(step) * RWW; \
      s_ok[slot] = *(const h16x8*)((p_rec + ro_ * 3) + urec); s_b[slot] = *(const h16x4*)((p_rec + ro_ * 3) + urec + 8); \
      s_kr[slot] = *(const h16x8*)((p_sh + ro_ * 2) + ush); s_v[slot] = (p_v + ro_)[uvoff]; } while (0)
#pragma unroll
    for (int uu = 0; uu < RW_U; ++uu) RW_LOAD(uu, uu);
    float S[4] = {0.f, 0.f, 0.f, 0.f};
    for (int t0 = 0; t0 < RW_NS; t0 += RW_U) {
      const bool islat = t0 >= CTX_LEN;
#pragma unroll
      for (int uu = 0; uu < RW_U; ++uu) {
        const float vv = (float)s_v[uu];
        const u32x4 p_ok = __builtin_bit_cast(u32x4, s_ok[uu]), p_kr = __builtin_bit_cast(u32x4, s_kr[uu]);
        const u32x2 p_bb = __builtin_bit_cast(u32x2, s_b[uu]);
        const unsigned om0 = p_ok[0], om1 = p_ok[1], kd0 = p_ok[2], kd1 = p_ok[3];
        const unsigned kk0 = p_kr[0], kk1 = p_kr[1], r0_ = p_kr[2], r1_ = p_kr[3];
        const unsigned b0_ = p_bb[0], b1_ = p_bb[1];
        float sa = fmix_lo(S[0], kk0, 0.f); sa = fmix_hi(S[1], kk0, sa);
        float sb = fmix_lo(S[2], kk1, 0.f); sb = fmix_hi(S[3], kk1, sb);
        sa = row_sum16(sa + sb);
        S[0] = fmix_lo(S[0], om0, S[0]); S[1] = fmix_hi(S[1], om0, S[1]); S[2] = fmix_lo(S[2], om1, S[2]); S[3] = fmix_hi(S[3], om1, S[3]);
        S[0] = fmix_lo(sa, b0_, S[0]); S[1] = fmix_hi(sa, b0_, S[1]); S[2] = fmix_lo(sa, b1_, S[2]); S[3] = fmix_hi(sa, b1_, S[3]);
        S[0] = fmix_lo(vv, kd0, S[0]); S[1] = fmix_hi(vv, kd0, S[1]); S[2] = fmix_lo(vv, kd1, S[2]); S[3] = fmix_hi(vv, kd1, S[3]);
        float y = fmix_lo(S[0], r0_, 0.f); y = fmix_hi(S[1], r0_, y);
        float y2 = fmix_lo(S[2], r1_, 0.f); y2 = fmix_hi(S[3], r1_, y2);
        y += y2;
        if (VAR == 0 && islat) {
          y = row_sum16(y);
          if (q == 0) yout[((size_t)dir * NL + row_of(t0 + uu)) * RWW + hh * 64 + vrow] = (h16)y;
        }
        if (VAR != 0) asm volatile("" :: "v"(y));
        const int nstep = t0 + uu + RW_U < RW_NS ? t0 + uu + RW_U : RW_NS - 1;
        if (VAR != 2) RW_LOAD(uu, nstep);
      }
    }
    if (VAR != 0) asm volatile("" :: "v"(S[0]), "v"(S[1]), "v"(S[2]), "v"(S[3]));
#undef RW_LOAD
  }
}

__device__ __forceinline__ void ph_rw_out(const Params& P, char* smem) {
  constexpr int LDG = 168;
  h16* sg = (h16*)smem;
  float* ys = (float*)(sg + 16 * LDG);
  float* st = ys + 16 * (RWW + 4);
  constexpr int LDY = RWW + 4;
  RwFeat F = rw_feat(P);
  const h16* g2t = (const h16*)(P.ws + O_G216);
  h16* yf = (h16*)(P.ws + O_PRW);
  h16* yb = yf + (size_t)NL * RWW;
  const int tid = TIDX, wave = tid >> 6, lane = tid & 63;
  for (int u = blockIdx.x; u < NL / 16; u += gridDim.x) {
    const int row0 = u * 16;
    __syncthreads();
    for (int i = tid; i < 16 * 20; i += NTHR) {
      const int tl = i / 20, g8 = i % 20;
      const h16x8 v = *(const h16x8*)(F.gls + (size_t)(row0 + tl) * 160 + g8 * 8);
      h16x8 o;
#pragma unroll
      for (int j = 0; j < 8; ++j) o[j] = (h16)(1.f / (1.f + __expf(-(float)v[j])));
      *(h16x8*)(sg + tl * LDG + g8 * 8) = o;
    }
    for (int it = tid; it < 16 * (RWW / 8); it += NTHR) {
      const int tl = it / (RWW / 8), j8 = (it % (RWW / 8)) * 8;
      const size_t o = (size_t)(row0 + tl) * RWW + j8;
      const h16x8 a = *(const h16x8*)(yf + o), b = *(const h16x8*)(yb + o);
      float y[8]; float s = 0.f;
#pragma unroll
      for (int j = 0; j < 8; ++j) { y[j] = (float)a[j] + (float)b[j]; s += y[j]; ys[tl * LDY + j8 + j] = y[j]; }
      s = sum8(s);
      const float mu = s * (1.f / 64.f);
      float s2 = 0.f;
#pragma unroll
      for (int j = 0; j < 8; ++j) { const float d_ = y[j] - mu; s2 += d_ * d_; }
      s2 = sum8(s2);
      if ((it & 7) == 0) { const int hh = j8 / 64; st[(tl * RW_H + hh) * 2] = mu; st[(tl * RW_H + hh) * 2 + 1] = rsqrtf(s2 * (1.f / 64.f) + RW_EPS); }
    }
    __syncthreads();
    h16x8 af[5];
#pragma unroll
    for (int ks = 0; ks < 5; ++ks) af[ks] = *(const h16x8*)(sg + (lane & 15) * LDG + ks * 32 + (lane >> 4) * 8);
    for (int nt = wave; nt < RWW / 16; nt += NTHR / 64) {
      const int n = nt * 16 + (lane & 15);
      f32x4 acc = (f32x4){0.f, 0.f, 0.f, 0.f};
#pragma unroll
      for (int ks = 0; ks < 5; ++ks) acc = MFMA16(af[ks], *(const h16x8*)(g2t + (size_t)n * 160 + ks * 32 + (lane >> 4) * 8), acc);
      const int hh = n / 64;
      const float gg = P.rw_gn_g[n], gb = P.rw_gn_b[n];
#pragma unroll
      for (int i = 0; i < 4; ++i) {
        const int tl = (lane >> 4) * 4 + i, row = row0 + tl;
        const float yn = (ys[tl * LDY + n] - st[(tl * RW_H + hh) * 2]) * st[(tl * RW_H + hh) * 2 + 1] * gg + gb;
        const float bon = F.bonus[(size_t)row * RW_H + hh] * (float)F.v[(size_t)row * RWW + n];
        yf[(size_t)row * RWW + n] = (h16)((yn + bon) * acc[i]);
      }
    }
  }
}

#ifdef EMU
static int emu_stop_at = -1;
#define PHASE_END(k) do { GRID_SYNC(); if (emu_stop_at == (k)) return; } while (0)
#else
#define PHASE_END(k) GRID_SYNC()
#endif
#ifndef REP_MASK
#define REP_MASK 0u
#endif
#define REP(k, ...) do { __VA_ARGS__; if (REP_MASK & (1u << (k))) { GRID_SYNC(); __VA_ARGS__; } } while (0)
__global__ void __launch_bounds__(NTHR, 2) mega_kernel(Params Pk) {
  DECL_SMEM;
#ifdef EMU
  #define PH(...) { const Params& P = Pk; __VA_ARGS__; }
#else
  typedef const __attribute__((address_space(4))) Params* KArg;
  #define XCP(f) P.f = q_->f;
  #define PH(...) { KArg q_ = (KArg)__builtin_amdgcn_kernarg_segment_ptr(); asm volatile("" : "+s"(q_)); Params P; \
                    PARAM_FIELDS(XCP) P.out = q_->out; P.ws = q_->ws; char* ws = P.ws; (void)ws; __VA_ARGS__; }
#endif
#ifndef EMU
  if (TIDX == 0) *(uint4*)(smem + 131072 + 512) = make_uint4(0u, 0u, 0u, 0u);
  __syncthreads();
  XcdBarrier gbar = xcd_barrier_post((unsigned*)(Pk.ws + O_BAR), (volatile LAS unsigned*)(smem + 131072 + 512));
#endif
#ifdef EMU
  char* ws = Pk.ws;
#endif
  #define xc1 ((float*)(ws + O_XC1))
  #define xc2 ((float*)(ws + O_XC2))
  REP(0, PH(ph_prologue(P, smem)));
  PHASE_END(0);
  REP(0, PH(ph_modulate0(P)));
  PHASE_END(1);
  REP(1, PH(gemm_phase<false, D, D, 0>((const h16*)(ws + O_ABUF), (const h16*)(ws + O_ABUF), (const h16*)(ws + O_WIN), NT, NP_EV, smem,
             EpiStoreH16{(h16*)(ws + O_P0), NP_EV, NP_EV})));
  REP(15, PH(ph_filter(P, smem)));
  PHASE_END(2);
  REP(16, PH(ph_hyena_pre(P, smem)));
  PH(ph_rope(P));
  PHASE_END(3);
  PH(ph_hyena_fft(P, smem));
  if (REP_MASK & (1u << 21)) { GRID_SYNC(); PH(ph_hyena_pre(P, smem)); GRID_SYNC(); PH(ph_hyena_fft(P, smem)); }
  PHASE_END(4);
  REP(17, PH(ph_hyena_post(P, smem)));
  PHASE_END(5);
  REP(3, PH(ph_ret_inter(P, smem)));
  PHASE_END(6);
  REP(4, PH(ph_ret_out(P, smem)));
  PHASE_END(7);
  REP(5, PH(gemm_phase<false, D, D, 0>((const h16*)(ws + O_ABUF), (const h16*)(ws + O_ABUF), (const h16*)(ws + O_WOUT), NT, D, smem,
             EpiStoreH16{(h16*)(ws + O_P0), D, D})));
  PHASE_END(8);
  REP(14, PH(ph_ln1<false, true>(P, 0, P.x, P.ctx, P.out, xc1, (const h16*)(ws + O_P0), NT, smem)));
  PHASE_END(9);
  REP(5, PH(gemm_phase<false, D, D, 0>((const h16*)(ws + O_ABUF), (const h16*)(ws + O_ABUF), (const h16*)(ws + O_WQ), NT, QW, smem,
             EpiStoreH16{(h16*)(ws + O_P0), QW, QW})));
  PHASE_END(10);
  REP(6, PH(ph_peer_select(P, 0, (const h16*)(ws + O_P0), NT, smem)));
  PHASE_END(11);
  if (REP_MASK & (1u << 23)) { PH(ph_peer_apply(P, 0, P.out, xc1, (float*)(ws + O_FFTS), NT, false, smem, (float*)(ws + O_P0))); GRID_SYNC(); }
  PH(ph_peer_apply(P, 0, P.out, xc1, xc2, NT, true, smem));
  PHASE_END(12);
  REP(7, PH(convert_layer_weights(P, 1, smem)));
  PHASE_END(13);
  REP(8, PH(gemm_phase<false, D, D, 0>((const h16*)(ws + O_ABUF), (const h16*)(ws + O_ABUF), (const h16*)(ws + O_WIN), NT, NP_OD, smem,
             EpiOddIn{(h16*)(ws + O_PRW), (h16*)(ws + O_PLRU)})));
  PHASE_END(14);
  REP(18, PH(ph_lru_a(P, smem)));
  PHASE_END(15);
  REP(19, PH(ph_lru_b(P)));
  PHASE_END(16);
  REP(20, PH(ph_lru_c(P, smem)));
  PHASE_END(17);
  REP(10, PH(ph_rw_feat(P, smem)));
  PHASE_END(18);
  if (REP_MASK & (1u << 24)) { PH(ph_rw_scan<1>(P)); GRID_SYNC(); }
  if (REP_MASK & (1u << 25)) { PH(ph_rw_scan<2>(P)); GRID_SYNC(); }
  REP(11, PH(ph_rw_scan<0>(P)));
  PHASE_END(19);
  PH(ph_rw_out(P, smem));
  if (REP_MASK & (1u << 22)) { GRID_SYNC(); PH(ph_rw_scan<0>(P)); GRID_SYNC(); PH(ph_rw_out(P, smem)); }
  PHASE_END(20);
  REP(13, PH(gemm_phase<true, RWW, LRUW, RWW / 64>((const h16*)(ws + O_PRW), (const h16*)(ws + O_MIXLRU), (const h16*)(ws + O_WOUT), NL, D, smem,
             EpiStoreH16{(h16*)(ws + O_FEAT), D, D})));
  PHASE_END(21);
  PH(ph_ln1<true, true>(P, 1, P.out, xc2, P.out, xc2, (const h16*)(ws + O_FEAT), NL, smem));
  PHASE_END(22);
  REP(13, PH(gemm_phase<false, D, D, 0>((const h16*)(ws + O_ABUF), (const h16*)(ws + O_ABUF), (const h16*)(ws + O_WQ), NL, QW, smem,
             EpiStoreH16{(h16*)(ws + O_FEAT), QW, QW})));
  PHASE_END(23);
  REP(6, PH(ph_peer_select(P, 1, (const h16*)(ws + O_FEAT), NL, smem)));
  PHASE_END(24);
  if (REP_MASK & (1u << 23)) { PH(ph_peer_apply(P, 1, P.out, xc2, xc2, NL, false, smem, (float*)(ws + O_FEAT))); GRID_SYNC(); }
  PH(ph_peer_apply(P, 1, P.out, xc2, xc2, NL, false, smem));
}

extern "C" void kernel_launch(void* const* d_in, const int* in_sizes, int n_in,
                              void* d_out, int out_size, void* d_ws, size_t ws_size,
                              hipStream_t stream) {
  (void)in_sizes; (void)out_size; (void)ws_size;
  Params p{};
  const float** fp = (const float**)&p;
  for (int i = 0; i < 46 && i < n_in; ++i) fp[i] = (const float*)d_in[i];
  p.out = (float*)d_out;
  p.ws = (char*)d_ws;
#ifdef EMU
  memset(d_ws, 0, 16384);
  emu_launch(dim3(MAXGRID), dim3(NTHR), LDS_BYTES, [=]() { mega_kernel(p); });
#else
  static int grid = 0;
  if (!grid) {
    int dev = 0, cus = 0, per_cu = 0;
    hipGetDevice(&dev);
    hipDeviceGetAttribute(&cus, hipDeviceAttributeMultiprocessorCount, dev);
    hipFuncSetAttribute((const void*)mega_kernel, hipFuncAttributeMaxDynamicSharedMemorySize, (int)LDS_BYTES);
    hipOccupancyMaxActiveBlocksPerMultiprocessor(&per_cu, mega_kernel, NTHR, LDS_BYTES);
    if (per_cu < 1) per_cu = 1;
    grid = cus * 1;
    if (grid > MAXGRID) grid = MAXGRID;
  }
  hipMemsetAsync(d_ws, 0, 16384, stream);
  mega_kernel<<<dim3(grid), dim3(NTHR), LDS_BYTES, stream>>>(p);
#endif
}
```

```cpp
#ifndef EMU
#include <hip/hip_runtime.h>
#endif
#include <stdint.h>
#include <stddef.h>

#ifndef D_MODEL
#define D_MODEL 2048
#endif
#ifndef BATCH
#define BATCH 2
#endif
#ifndef SEQ
#define SEQ 16384
#endif
#ifndef GRID_W
#define GRID_W 64
#endif
#ifndef CTX_LEN
#define CTX_LEN 256
#endif
#ifndef PEER_KEYS
#define PEER_KEYS 128
#endif
#ifndef RET_HEADS
#define RET_HEADS 8
#endif
#ifndef LRU_BLOCKS
#define LRU_BLOCKS 16
#endif

typedef _Float16 h16;
typedef h16 h16x8 __attribute__((ext_vector_type(8)));
typedef h16 h16x4 __attribute__((ext_vector_type(4)));
typedef h16 h16x2 __attribute__((ext_vector_type(2)));
typedef float f32x4 __attribute__((ext_vector_type(4)));
typedef unsigned u32x2 __attribute__((ext_vector_type(2)));
typedef unsigned u32x4 __attribute__((ext_vector_type(4)));

constexpr int NTHR = 512;
#define DPT ((D_MODEL + 511) / 512)
constexpr int D = D_MODEL;
constexpr int D6 = 6 * D;
constexpr int HY_CH = D / 2;
constexpr int RETW = D / 2;
constexpr int RET_HD = RETW / RET_HEADS;
constexpr int RET_C = 128;
constexpr int EVEN_IN = 3 * HY_CH + 4 * RETW;
constexpr int RWW = D / 2;
constexpr int RW_HD = 64;
constexpr int RW_H = RWW / RW_HD;
constexpr int RW_SHIFT = 3 * RWW + 64 + 64 + 160;
constexpr int LRUW = D / 2;
constexpr int LRU_BD = LRUW / LRU_BLOCKS;
constexpr int ODD_IN = RW_SHIFT + 2 * LRUW;
constexpr int PEER_E = PEER_KEYS * PEER_KEYS;
constexpr int PEER_H = 8;
constexpr int PEER_QD = 256;
constexpr int QW = PEER_H * PEER_QD;
constexpr int TOPK = 16;
constexpr int NSEL = PEER_H * TOPK;
constexpr int NL = BATCH * SEQ;
constexpr int NC = BATCH * CTX_LEN;
constexpr int NT = NL + NC;
constexpr int GRID_ROWS = SEQ / GRID_W;
constexpr int FH = 64;
constexpr int FE = 33;
constexpr int ru256(int x) { return (x + 255) / 256 * 256; }
constexpr int NP_EV = ru256(EVEN_IN);
constexpr int NP_OD = ru256(ODD_IN);
constexpr float ALPHA = 1.41421356237309515f;
constexpr float LN_EPS = 1e-5f;
constexpr float RET_EPS = 1e-5f;
constexpr float RW_EPS = 64e-5f;
constexpr int LRU_T = 64;
constexpr int LRU_LCH = SEQ / LRU_T, LRU_CCH = CTX_LEN / LRU_T, LRU_NCH = LRU_LCH + LRU_CCH;
constexpr int RET_LCH = SEQ / RET_C, RET_CCH = CTX_LEN / RET_C, RET_NCH = RET_LCH + RET_CCH;
static_assert(RET_HD == 128, "retention head dim");
static_assert(LRU_BD == 64, "lru block dim");
static_assert(NT % 256 == 0 && NL % 256 == 0, "rows");
static_assert(D % 128 == 0 && D >= 256, "K");

constexpr size_t LDS_BYTES = 131072 + 1024;

constexpr size_t al256(size_t x) { return (x + 255) / 256 * 256; }
constexpr size_t cmax(size_t a, size_t b) { return a > b ? a : b; }
#ifdef EMU
constexpr int MAXGRID = 8;
#else
constexpr int MAXGRID = 256;
#endif
constexpr size_t O_BAR = 0;
constexpr size_t O_MOD = 16384;
constexpr size_t O_ROPE = O_MOD + al256((size_t)2 * 3 * D6 * 4);
constexpr size_t O_TW = O_ROPE + al256((size_t)2 * (SEQ + CTX_LEN) * 64 * 4);
constexpr size_t O_XC1 = O_TW + al256((size_t)SEQ * 4);
constexpr size_t O_XC2 = O_XC1 + al256((size_t)NC * D * 4);
constexpr size_t O_WIN = O_XC2 + al256((size_t)NC * D * 4);
constexpr size_t O_WOUT = O_WIN + al256((size_t)cmax(NP_EV, NP_OD) * D * 2);
constexpr size_t O_WQ = O_WOUT + al256((size_t)D * D * 2);
constexpr size_t O_TABU = O_WQ + al256((size_t)QW * D * 2);
constexpr size_t O_TABV = O_TABU + al256((size_t)PEER_E * D * 2);
constexpr size_t O_KEYS16 = O_TABV + al256((size_t)PEER_E * D * 2);
constexpr size_t O_LW16 = O_KEYS16 + al256((size_t)PEER_H * 2 * PEER_KEYS * 128 * 2);
constexpr size_t O_RW16 = O_LW16 + al256((size_t)2 * LRU_BLOCKS * 2 * 64 * 64 * 2);
constexpr size_t O_G216 = O_RW16 + al256((size_t)2 * 2 * RWW * 64 * 2);
constexpr size_t O_ABUF = O_G216 + al256((size_t)RWW * 160 * 2);
constexpr size_t O_SELI = O_ABUF + al256((size_t)NT * D * 2);
constexpr size_t O_SELG = O_SELI + al256((size_t)NT * NSEL * 4);
constexpr size_t O_ARENA = O_SELG + al256((size_t)NT * NSEL * 4);
constexpr size_t O_P0 = O_ARENA;
constexpr size_t SZ_P0 = cmax((size_t)NT * NP_EV * 2, cmax((size_t)NT * D * 4, (size_t)NT * QW * 4));
constexpr size_t O_H3 = O_P0 + al256(SZ_P0);
constexpr size_t O_FILT = O_H3 + al256((size_t)(SEQ + CTX_LEN) * FH * 4);
constexpr size_t O_FILTC = O_FILT + al256((size_t)HY_CH * 2 * SEQ * 4);
constexpr size_t O_FFTS = O_FILTC + al256((size_t)HY_CH * 2 * CTX_LEN * 4);
constexpr size_t END_L0 = O_FFTS + al256((size_t)MAXGRID * 2 * SEQ * 8);
constexpr size_t O_PRW = O_ARENA;
constexpr size_t O_PLRU = O_PRW + al256((size_t)NT * RW_SHIFT * 2);
constexpr size_t O_FEAT = O_PLRU + al256((size_t)NT * 2 * LRUW * 2);
constexpr size_t O_MIXLRU = O_FEAT + al256(cmax((size_t)5 * NT * RWW * 2, cmax((size_t)NL * D * 4, (size_t)NL * QW * 4)));
constexpr size_t O_GLS = O_MIXLRU + al256((size_t)NL * LRUW * 2);
constexpr size_t O_BONUS = O_GLS + al256((size_t)NT * 160 * 2);
constexpr size_t O_LSUM = O_BONUS + al256((size_t)NT * RW_H * 4);
constexpr size_t O_LCAR = O_LSUM + al256((size_t)2 * BATCH * LRU_NCH * LRUW * 8);
constexpr size_t O_RWST = O_LCAR + al256((size_t)2 * BATCH * LRU_NCH * LRUW * 4);
constexpr size_t END_L1 = O_RWST + 256;
constexpr size_t WS_NEED = cmax(END_L0, END_L1);

#define PARAM_FIELDS(X) \
  X(x) X(c) X(ctx) X(c_ctx) X(ada_w) X(ada_b) X(ln_g) X(ln_b) \
  X(ev_w_in) X(hy_short_w) X(hy_short_b) X(f_w1) X(f_b1) X(f_w2) X(f_b2) X(f_w3) X(f_b3) X(f_w4) X(f_b4) X(f_freq) X(hy_bias) X(ev_w_out) \
  X(od_w_in) X(rw_mu) X(rw_w0) X(rw_w2) X(rw_a0) X(rw_a2) X(rw_g2) X(rw_k_k) X(rw_k_a) X(rw_r_k) X(rw_gn_g) X(rw_gn_b) \
  X(lru_conv_w) X(lru_conv_b) X(lru_wa) X(lru_ba) X(lru_wx) X(lru_bx) X(lru_lam) X(od_w_out) \
  X(peer_wq) X(peer_keys) X(peer_u) X(peer_v)
struct Params {
#define X(f) const float* f;
  PARAM_FIELDS(X)
#undef X
  float* out;
  char* ws;
};

#ifdef EMU
#define MFMA16(a, b, c) emu_mfma16(a, b, c)
#else
#define MFMA16(a, b, c) __builtin_amdgcn_mfma_f32_16x16x32_f16(a, b, c, 0, 0, 0)
#endif
__device__ __forceinline__ float sigmoidf_(float x) { return 1.0f / (1.0f + expf(-x)); }
__device__ __forceinline__ float siluf_(float x) { return x * sigmoidf_(x); }
__device__ __forceinline__ float softplusf_(float x) { return x > 20.f ? x : log1pf(expf(x)); }
__device__ __forceinline__ float geluf_(float x) { return 0.5f * x * (1.0f + tanhf(0.7978845608028654f * (x + 0.044715f * x * x * x))); }

#ifdef EMU
#define GRID_SYNC() emu_grid_sync()
#define DECL_SMEM char* smem = emu_get_smem()
#else
#define DECL_SMEM extern __shared__ __attribute__((aligned(16))) char smem[]
#endif

#ifdef EMU
#define TIDX ((int)threadIdx.x)
#else
__device__ __forceinline__ int tid_fn() { int t = threadIdx.x; asm volatile("" : "+v"(t)); return t; }
#define TIDX tid_fn()
#endif
__device__ __forceinline__ void block_sum2(float& a, float& b, float* red) {
#ifdef EMU
  __syncthreads();
  if (TIDX == 0) { red[0] = 0; red[1] = 0; }
  __syncthreads();
  for (int i = 0; i < NTHR; ++i) { if ((int)TIDX == i) { red[0] += a; red[1] += b; } }
  __syncthreads();
  a = red[0]; b = red[1];
  __syncthreads();
#else
  for (int m = 32; m >= 1; m >>= 1) { a += __shfl_xor(a, m); b += __shfl_xor(b, m); }
  __syncthreads();
  if ((TIDX & 63) == 0) { red[(TIDX >> 6) * 2] = a; red[(TIDX >> 6) * 2 + 1] = b; }
  __syncthreads();
  a = 0; b = 0;
  for (int w = 0; w < NTHR / 64; ++w) { a += red[w * 2]; b += red[w * 2 + 1]; }
  __syncthreads();
#endif
}

#ifdef EMU
__device__ __forceinline__ float row_sum16(float v) { v += __shfl_xor(v, 1); v += __shfl_xor(v, 2); v += __shfl_xor(v, 4); v += __shfl_xor(v, 8); return v; }
__device__ __forceinline__ float wave_sum(float v) { v = row_sum16(v); v += __shfl_xor(v, 16); v += __shfl_xor(v, 32); return v; }
#else
template <int CTRL> __device__ __forceinline__ float dppf(float v) {
  return __builtin_bit_cast(float, __builtin_amdgcn_update_dpp(0, __builtin_bit_cast(int, v), CTRL, 0xF, 0xF, true));
}
__device__ __forceinline__ float row_sum16(float v) { v += dppf<0xB1>(v); v += dppf<0x4E>(v); v += dppf<0x124>(v); v += dppf<0x128>(v); return v; }
__device__ __forceinline__ float wave_sum(float v) {
  v = row_sum16(v);
  const float r0 = __builtin_bit_cast(float, __builtin_amdgcn_readlane(__builtin_bit_cast(int, v), 0));
  const float r1 = __builtin_bit_cast(float, __builtin_amdgcn_readlane(__builtin_bit_cast(int, v), 16));
  const float r2 = __builtin_bit_cast(float, __builtin_amdgcn_readlane(__builtin_bit_cast(int, v), 32));
  const float r3 = __builtin_bit_cast(float, __builtin_amdgcn_readlane(__builtin_bit_cast(int, v), 48));
  return (r0 + r1) + (r2 + r3);
}
#endif
__device__ __forceinline__ void row_decode(int row, int& isctx, int& b, int& t) {
  if (row < NL) { isctx = 0; b = row / SEQ; t = row % SEQ; }
  else { int r = row - NL; isctx = 1; b = r / CTX_LEN; t = r % CTX_LEN; }
}
__device__ __forceinline__ const float* mod_ptr(const Params& P, int layer, int row, int which) {
  int mr = row < NL ? row / SEQ : BATCH;
  return (const float*)(P.ws + O_MOD) + ((size_t)(layer * 3 + mr) * 6 + which) * D;
}

#ifndef EMU
#define XB_TMO      128
#define XB_XCNT(j)  (256  + 64 * (j))
#define XB_XSUB(j)  (1280 + 64 * (j))
#define XB_XGEN(j)  (2304 + 64 * (j))
#define XB_TOP      3328
#define XB_TOPGEN   3392
#define XCD_BAR_WORDS 3456
#define XB_SPIN_CAP (1u << 22)
#define LAS __attribute__((address_space(3)))
__device__ __forceinline__ unsigned xb_ld(unsigned* p)              { return __hip_atomic_load(p, __ATOMIC_RELAXED, __HIP_MEMORY_SCOPE_AGENT); }
__device__ __forceinline__ unsigned xb_add(unsigned* p, unsigned v) { return __hip_atomic_fetch_add(p, v, __ATOMIC_RELAXED, __HIP_MEMORY_SCOPE_AGENT); }
__device__ __forceinline__ unsigned xb_xcc_id() { return (unsigned)__builtin_amdgcn_s_getreg((3 << 11) | 20) & 0xFu; }
#define XB_SPIN(cond, bar) do { unsigned _sp = 0; while (cond) { __builtin_amdgcn_s_sleep(1); \
    if ((++_sp & 255u) == 0u) { if (xb_ld(&(bar)[XB_TMO])) break; if (_sp > XB_SPIN_CAP) { atomicAdd(&(bar)[XB_TMO], 1u); break; } } } } while (0)
struct XcdBarrier { unsigned* bar; unsigned x; volatile LAS unsigned* st; };
__device__ __forceinline__ XcdBarrier xcd_barrier_post(unsigned* bar, volatile LAS unsigned* st) {
    XcdBarrier b; b.bar = bar; b.x = xb_xcc_id(); b.st = st;
    if (threadIdx.x == 0) (void)xb_add(&bar[XB_XCNT(b.x)], 1u);
    return b;
}
__device__ __forceinline__ void xcd_barrier_complete(unsigned* bar, unsigned x, unsigned& nloc, unsigned& nx) {
    const unsigned G = gridDim.x * gridDim.y * gridDim.z;
    unsigned sum, cnt, mine, sp = 0u;
    for (;;) {
        sum = 0u; cnt = 0u; mine = 0u;
#pragma unroll
        for (unsigned j = 0; j < 16; ++j) { const unsigned c = xb_ld(&bar[XB_XCNT(j)]); sum += c; cnt += (c > 0u) ? 1u : 0u; mine = (j == x) ? c : mine; }
        if (sum == G) break;
        __builtin_amdgcn_s_sleep(1);
        if ((++sp & 255u) == 0u) { if (xb_ld(&bar[XB_TMO])) break; if (sp > XB_SPIN_CAP) { atomicAdd(&bar[XB_TMO], 1u); break; } }
    }
    nloc = mine > 0u ? mine : 1u; nx = cnt > 0u ? cnt : 1u;
}
__device__ __forceinline__ void xcd_barrier(const XcdBarrier& b) {
    asm volatile("s_waitcnt vmcnt(0)" ::: "memory");
    __syncthreads();
    if (threadIdx.x == 0) {
        unsigned* bar = b.bar;
        __builtin_amdgcn_s_waitcnt(0);
        unsigned nloc = b.st[0], nx = b.st[1];
        if (nloc == 0u) { xcd_barrier_complete(bar, b.x, nloc, nx); b.st[0] = nloc; b.st[1] = nx; }
        const unsigned old = xb_add(&bar[XB_XSUB(b.x)], 1u);
        const unsigned gen = old / nloc;
        if (old + 1u == (gen + 1u) * nloc) {
            __builtin_amdgcn_fence(__ATOMIC_RELEASE, "agent");
            asm volatile("s_waitcnt vmcnt(0)" ::: "memory");
            const unsigned og = xb_add(&bar[XB_TOP], 1u);
            const unsigned tg = og / nx;
            if (og + 1u == (tg + 1u) * nx) xb_add(&bar[XB_TOPGEN], 1u);
            else XB_SPIN(xb_ld(&bar[XB_TOPGEN]) == tg, bar);
            __builtin_amdgcn_fence(__ATOMIC_ACQUIRE, "agent");
            xb_add(&bar[XB_XGEN(b.x)], 1u);
            asm volatile("s_waitcnt vmcnt(0)" ::: "memory");
        } else {
            XB_SPIN(xb_ld(&bar[XB_XGEN(b.x)]) == gen, bar);
            __builtin_amdgcn_fence(__ATOMIC_ACQUIRE, "agent");
            asm volatile("s_waitcnt vmcnt(0)" ::: "memory");
        }
    }
    __syncthreads();
}
#define GRID_SYNC() xcd_barrier(gbar)
#endif

#ifndef EMU
constexpr int G_BK = 64, G_HALF = 128, G_HT = G_HALF * G_BK;
__device__ __forceinline__ int g_lds_byte(int r, int c) {
  int st = (r >> 4) * 2 + (c >> 5), rr = r & 15, cc = c & 31, ob = rr * 64 + cc * 2;
  return st * 1024 + (ob ^ (((ob >> 9) & 1) << 5));
}
__device__ __forceinline__ void g_stage_rc(int b, int& R, int& C) {
  int st = b / 1024, sb = b % 1024, swz = sb ^ (((sb >> 9) & 1) << 5);
  R = (st >> 1) * 16 + swz / 64; C = (st & 1) * 32 + (swz % 64) / 2;
}
#else
template <bool SPLIT, int lda0, int lda1, int ksp, class Epi>
__device__ __forceinline__ void gemm_tile(const h16* A0, const h16* A1,
                          const h16* Bt, int brow, int bcol, char* smem, const Epi& epi) {
  constexpr int K = D;
  for (int o = TIDX; o < 256 * 64; o += NTHR) {
    int r = brow + o / 64, c0 = bcol + (o % 64) * 4;
    f32x4 acc = (f32x4){0.f, 0.f, 0.f, 0.f};
    for (int k = 0; k < K; ++k) {
      int kt = k / 64;
      float a = (!SPLIT || kt < ksp) ? (float)A0[(size_t)r * lda0 + k] : (float)A1[(size_t)r * lda1 + (k - ksp * 64)];
      for (int q = 0; q < 4; ++q) acc[q] += a * (float)Bt[(size_t)(c0 + q) * K + k];
    }
    epi(r, c0, acc);
  }
}
#endif

__device__ __forceinline__ void gemm_tile_coords(int tile, int nM, int nN, int& pm, int& pn) {
  const int band = tile / (8 * nN), rem = tile % (8 * nN);
  const int bm0 = band * 8, bsz = (nM - bm0) < 8 ? (nM - bm0) : 8;
  if (bsz == 8) { pm = bm0 + rem % 8; pn = rem / 8; } else { pm = bm0 + rem % bsz; pn = rem / bsz; }
}
#ifdef EMU
template <bool SPLIT, int lda0, int lda1, int ksp, class Epi>
__device__ __forceinline__ void gemm_phase(const h16* A0, const h16* A1,
                                           const h16* Bt, int M, int N, char* smem, const Epi& epi) {
  const int nM = M / 256, nN = N / 256, ntile = nM * nN;
  for (int tile = blockIdx.x; tile < ntile; tile += gridDim.x) {
    int pm, pn; gemm_tile_coords(tile, nM, nN, pm, pn);
    __syncthreads();
    gemm_tile<SPLIT, lda0, lda1, ksp>(A0, A1, Bt, pm * 256, pn * 256, smem, epi);
  }
}
#else
template <bool SPLIT, int lda0, int lda1, int ksp, class Epi>
__device__ __forceinline__ void gemm_phase(const h16* A0, const h16* A1,
                                           const h16* Bt, int M, int N, char* smem, const Epi& epi) {
  constexpr int K = D;
  constexpr int nt = K / G_BK;
  static_assert(nt % 2 == 0 && nt >= 4, "K tiles");
  const int nM = M / 256, nN = N / 256, ntile = nM * nN;
  const int xcd_ = blockIdx.x & 7, slot_ = blockIdx.x >> 3, gstep_ = ((int)gridDim.x >> 3) * 8 * 32 / 32;
  (void)gstep_;
  int rnd_ = 0;
  int tile = (rnd_ * 8 + xcd_) * ((int)gridDim.x >> 3) + slot_;
  __syncthreads();
  if (tile >= ntile) return;
  h16* shm = (h16*)smem;
  #define SA(b,h) (shm+((b)*2+(h))*G_HT)
  #define SB(b,h) (shm+(4+(b)*2+(h))*G_HT)
  #define APTR(kt) ((!SPLIT || (kt) < ksp) ? A0 + (long)(kt) * G_BK : A1 + (long)((kt) - ksp) * G_BK)
  #define ALD(kt) ((!SPLIT || (kt) < ksp) ? lda0 : lda1)
  #define STAGE_A(T,P_,br,kt) do{ const h16* _base = APTR(kt); long _ld = ALD(kt); \
    for(int _i=0;_i<2;++_i){int _b=(T)*16+_i*8192;int _r,_c;g_stage_rc(_b,_r,_c); \
      __builtin_amdgcn_global_load_lds((const unsigned*)(_base+(long)((br)+_r)*_ld+_c), \
        (unsigned*)((char*)(P_)+_b),16,0,0);}}while(0)
  #define STAGE_B(T,P_,br,kt) do{long _g=(long)(br)*K+(long)(kt)*G_BK; \
    for(int _i=0;_i<2;++_i){int _b=(T)*16+_i*8192;int _r,_c;g_stage_rc(_b,_r,_c); \
      __builtin_amdgcn_global_load_lds((const unsigned*)(Bt+_g+(long)_r*K+_c), \
        (unsigned*)((char*)(P_)+_b),16,0,0);}}while(0)
  #define LDA(dst,b,h) for(int m=0;m<4;++m)for(int k=0;k<2;++k) \
    dst[m][k]=*reinterpret_cast<const h16x8*>((char*)SA(b,h)+g_lds_byte(wr*64+m*16+fr,k*32+fq*8))
  #define LDB(dst,b,h) for(int n=0;n<2;++n)for(int k=0;k<2;++k) \
    dst[n][k]=*reinterpret_cast<const h16x8*>((char*)SB(b,h)+g_lds_byte(wc*32+n*16+fr,k*32+fq*8))
  #define MMA(ai,bj,At_,Bt_) do{__builtin_amdgcn_s_setprio(1); \
    for(int m=0;m<4;++m)for(int n=0;n<2;++n)for(int k=0;k<2;++k) \
      acc[ai][bj][m][n]=__builtin_amdgcn_mfma_f32_16x16x32_f16(Bt_[n][k],At_[m][k],acc[ai][bj][m][n],0,0,0); \
    __builtin_amdgcn_s_setprio(0);}while(0)
  #define WAIT_V(n) asm volatile("s_waitcnt vmcnt(" #n ")":::"memory")
  #define WAIT_L(n) asm volatile("s_waitcnt lgkmcnt(" #n ")":::"memory")
  #define BAR __builtin_amdgcn_s_barrier()
  #define SCHED __builtin_amdgcn_sched_barrier(0)
  int pm, pn; gemm_tile_coords(tile, nM, nN, pm, pn);
  int brow = __builtin_amdgcn_readfirstlane(pm) * 256, bcol = __builtin_amdgcn_readfirstlane(pn) * 256;
  {
    const int tx = TIDX; const int wr = tx >> 8;
    STAGE_B(tx,SB(0,0),bcol,0); STAGE_A(tx,SA(0,0),brow,0);
    STAGE_B(tx,SB(0,1),bcol+G_HALF,0); STAGE_A(tx,SA(0,1),brow+G_HALF,0);
    if(wr==1)BAR;
    WAIT_V(4); BAR;
    STAGE_B(tx,SB(1,0),bcol,1); STAGE_A(tx,SA(1,0),brow,1); STAGE_B(tx,SB(1,1),bcol+G_HALF,1);
    WAIT_V(6); BAR;
  }
  for (;;) {
    const int nxt = ((rnd_ + 1) * 8 + xcd_) * ((int)gridDim.x >> 3) + slot_;
    const bool has_next = nxt < ntile;
    int qm, qn; gemm_tile_coords(has_next ? nxt : tile, nM, nN, qm, qn);
    const int nbrow = __builtin_amdgcn_readfirstlane(qm) * 256, nbcol = __builtin_amdgcn_readfirstlane(qn) * 256;
    int tx = TIDX;
    int wid=tx>>6,lane=tx&63,wr=wid>>2,wc=wid&3,fr=lane&15,fq=lane>>4;
    f32x4 acc[2][2][4][2]={};
    h16x8 At[4][2],B0[2][2],B1[2][2];
    for(int t=0;t<nt;t+=2){
      const bool wrap = t + 2 >= nt;
      const int r2 = wrap ? nbrow : brow, c2 = wrap ? nbcol : bcol, k2 = wrap ? 0 : t + 2, k3 = k2 + 1;
      LDB(B0,0,0); SCHED; LDA(At,0,0); STAGE_A(tx,SA(1,1),brow+G_HALF,t+1);
      WAIT_L(8); BAR; WAIT_L(0); MMA(0,0,At,B0); BAR; SCHED;
      LDB(B1,0,1); STAGE_B(tx,SB(0,0),c2,k2);
      BAR; WAIT_L(0); MMA(0,1,At,B1); BAR;
      LDA(At,0,1); STAGE_A(tx,SA(0,0),r2,k2);
      BAR; WAIT_L(0); MMA(1,0,At,B0); BAR; SCHED;
      STAGE_B(tx,SB(0,1),c2+G_HALF,k2);
      WAIT_V(6); BAR; MMA(1,1,At,B1); BAR;
      LDB(B0,1,0); SCHED; LDA(At,1,0); STAGE_A(tx,SA(0,1),r2+G_HALF,k2);
      WAIT_L(8); BAR; WAIT_L(0); MMA(0,0,At,B0); BAR; SCHED;
      LDB(B1,1,1); STAGE_B(tx,SB(1,0),c2,k3);
      BAR; WAIT_L(0); MMA(0,1,At,B1); BAR;
      LDA(At,1,1); STAGE_A(tx,SA(1,0),r2,k3);
      BAR; WAIT_L(0); MMA(1,0,At,B0); BAR; SCHED;
      STAGE_B(tx,SB(1,1),c2+G_HALF,k3);
      WAIT_V(6); BAR; MMA(1,1,At,B1); BAR;
    }
    int tz=TIDX; wid=tz>>6; lane=tz&63; wr=wid>>2; wc=wid&3; fr=lane&15; fq=lane>>4;
    _Pragma("unroll") for(int ai=0;ai<2;++ai) _Pragma("unroll") for(int bj=0;bj<2;++bj) _Pragma("unroll") for(int m=0;m<4;++m) _Pragma("unroll") for(int n=0;n<2;++n)
      epi(brow+ai*G_HALF+wr*64+m*16+fr, bcol+bj*G_HALF+wc*32+n*16+fq*4, acc[ai][bj][m][n]);
    if (!has_next) break;
    tile = nxt; brow = nbrow; bcol = nbcol; ++rnd_;
  }
  WAIT_V(0);
  { const int tq = TIDX; if ((tq >> 8) == 0) BAR; }
  __syncthreads();
  #undef SA
  #undef SB
  #undef APTR
  #undef ALD
  #undef STAGE_A
  #undef STAGE_B
  #undef LDA
  #undef LDB
  #undef MMA
  #undef WAIT_V
  #undef WAIT_L
  #undef BAR
  #undef SCHED
}
#endif

struct EpiStoreH16 { h16* C; int ldc; int ncols;
  __device__ __forceinline__ void operator()(int r, int c, f32x4 v) const {
    if (c < ncols) { h16x4 o; o[0] = (h16)v[0]; o[1] = (h16)v[1]; o[2] = (h16)v[2]; o[3] = (h16)v[3]; *(h16x4*)(C + (size_t)r * ldc + c) = o; } } };
struct EpiStoreF32 { float* C; int ldc;
  __device__ __forceinline__ void operator()(int r, int c, f32x4 v) const { *(f32x4*)(C + (size_t)r * ldc + c) = v; } };
struct EpiOddIn { h16* prw; h16* plru;
  __device__ __forceinline__ void operator()(int r, int c, f32x4 v) const {
    h16x4 o; o[0] = (h16)v[0]; o[1] = (h16)v[1]; o[2] = (h16)v[2]; o[3] = (h16)v[3];
    if (c < RW_SHIFT) *(h16x4*)(prw + (size_t)r * RW_SHIFT + c) = o;
    else if (c < ODD_IN) *(h16x4*)(plru + (size_t)r * (2 * LRUW) + (c - RW_SHIFT)) = o; } };
static_assert(RW_SHIFT % 4 == 0 && ODD_IN % 4 == 0 && EVEN_IN % 4 == 0, "vector epilogue");

__device__ __forceinline__ void task_transpose(const float* W, h16* Wt, int K, int N, int unit, char* smem) {
  float* tile = (float*)smem;
  const int nkt = K / 64;
  const int kt = unit % nkt, ntile = unit / nkt;
  const int k0 = kt * 64, n0 = ntile * 64;
  __syncthreads();
#pragma unroll 4
  for (int i = TIDX; i < 64 * 64; i += NTHR) {
    int kk = i / 64, nn = i % 64;
    tile[kk * 65 + nn] = (n0 + nn < N) ? W[(size_t)(k0 + kk) * N + n0 + nn] : 0.f;
  }
  __syncthreads();
  for (int i = TIDX; i < 64 * 64; i += NTHR) {
    int nn = i / 64, kk = i % 64;
    Wt[(size_t)(n0 + nn) * K + k0 + kk] = (h16)tile[kk * 65 + nn];
  }
}
__device__ __forceinline__ void task_convert(const float* src, h16* dst, size_t n, int unit, int nunits) {
  size_t n4 = n / 4;
  for (size_t i = (size_t)unit * NTHR + TIDX; i < n4; i += (size_t)nunits * NTHR) {
    const float4 v = ((const float4*)src)[i];
    h16x4 o; o[0] = (h16)v.x; o[1] = (h16)v.y; o[2] = (h16)v.z; o[3] = (h16)v.w;
    ((h16x4*)dst)[i] = o;
  }
}

__device__ __forceinline__ void task_mod(const Params& P, int unit, char* smem) {
  float* sc = (float*)smem;
  float* part = sc + 3 * D;
  const int tid = TIDX, wave = tid >> 6, lane = tid & 63;
  __syncthreads();
  for (int i = tid; i < 3 * D; i += NTHR) {
    int r = i / D, k = i % D;
    float v = r < BATCH ? P.c[r * D + k] : P.c_ctx[k];
    sc[i] = siluf_(v);
  }
  __syncthreads();
  const int idx = unit * 64 + lane;
  const int l = idx / D6, j = idx % D6;
  const float* w = P.ada_w + (size_t)l * D * D6 + j;
  float a0 = 0, a1 = 0, a2 = 0;
  constexpr int KW = D / 8;
#pragma unroll 8
  for (int k = wave * KW; k < (wave + 1) * KW; ++k) { const float wv = w[(size_t)k * D6]; a0 += sc[k] * wv; a1 += sc[D + k] * wv; a2 += sc[2 * D + k] * wv; }
  part[(wave * 3 + 0) * 64 + lane] = a0; part[(wave * 3 + 1) * 64 + lane] = a1; part[(wave * 3 + 2) * 64 + lane] = a2;
  __syncthreads();
  if (tid < 192) {
    const int r = tid / 64, jj = tid % 64;
    float s = 0.f;
#pragma unroll
    for (int wv = 0; wv < 8; ++wv) s += part[(wv * 3 + r) * 64 + jj];
    const int id2 = unit * 64 + jj, l2 = id2 / D6, j2 = id2 % D6;
    float* mod = (float*)(P.ws + O_MOD);
    mod[(size_t)(l2 * 3 + r) * D6 + j2] = s + P.ada_b[l2 * D6 + j2];
  }
}
static_assert(BATCH == 2, "mod rows");

__device__ __forceinline__ void task_tables(const Params& P, int unit) {
  float* rc = (float*)(P.ws + O_ROPE);
  float* rs = rc + (size_t)(SEQ + CTX_LEN) * 64;
  const int nrope = (SEQ + CTX_LEN) * 64;
  int i = unit * NTHR + TIDX;
  if (i < nrope) {
    int pos = i / 64, f = i % 64;
    float rowv, colv;
    if (pos < SEQ) { rowv = (float)(pos / GRID_W); colv = (float)(pos % GRID_W); }
    else { rowv = (float)((pos - SEQ) - CTX_LEN); colv = 0.f; }
    const int nf = RET_HD / 4;
    int fi = f % nf;
    float freq = powf(10000.0f, -(float)fi / (float)nf);
    float ang = (f < nf ? rowv : colv) * freq;
    rc[i] = cosf(ang); rs[i] = sinf(ang);
  }
  int j = i - nrope;
  if (j >= 0 && j < SEQ / 2) {
    float2* tw = (float2*)(P.ws + O_TW);
    float s, c;
    sincospif(-2.0f * (float)j / (float)SEQ, &s, &c);
    tw[j] = make_float2(c, s);
  }
}

__device__ __forceinline__ void task_h3(const Params& P, int unit, char* smem) {
  float* hin = (float*)smem;
  float* hout = hin + 8 * 64;
  float* h3 = (float*)(P.ws + O_H3);
  const int pl = TIDX / 64, j = TIDX % 64;
  const int gp = unit * 8 + pl;
  const bool isc = gp >= SEQ;
  const int L = isc ? CTX_LEN : SEQ;
  const int pos = isc ? gp - SEQ : gp;
  const float t = (float)pos / (float)(L - 1);
  const float fr = P.f_freq[j];
  __syncthreads();
  float acc = P.f_b1[j];
  acc += t * P.f_w1[0 * FH + j];
#pragma unroll 1
  for (int b = 0; b < 16; ++b) {
    float band = 1e-4f + (15.0f - 1e-4f) * (float)b / 15.0f;
    float s, c;
    sincospif(2.0f * (float)pos * band / (float)L, &s, &c);
    acc += c * P.f_w1[(1 + b) * FH + j];
    acc += (-s) * P.f_w1[(17 + b) * FH + j];
  }
  hin[pl * 64 + j] = sinf(fr * acc);
  __syncthreads();
  acc = P.f_b2[j];
#pragma unroll 8
  for (int i = 0; i < FH; ++i) acc += hin[pl * 64 + i] * P.f_w2[i * FH + j];
  hout[pl * 64 + j] = sinf(fr * acc);
  __syncthreads();
  acc = P.f_b3[j];
#pragma unroll 8
  for (int i = 0; i < FH; ++i) acc += hout[pl * 64 + i] * P.f_w3[i * FH + j];
  if (gp < SEQ + CTX_LEN) h3[(size_t)gp * FH + j] = sinf(fr * acc);
}
static_assert((SEQ + CTX_LEN) % 8 == 0, "h3 units");

constexpr int P6_NB = D / 32;
constexpr int P6_ROWB = P6_NB * 24 + P6_NB;
typedef unsigned u32x6 __attribute__((ext_vector_type(6)));
typedef float f32x32 __attribute__((ext_vector_type(32)));
typedef float f32x16 __attribute__((ext_vector_type(16)));
__device__ __forceinline__ float p6_scale_from_byte(unsigned b) { return __builtin_bit_cast(float, b << 23); }
__device__ __forceinline__ unsigned p6_scale_byte(float amax) {
  const unsigned e = (__builtin_bit_cast(unsigned, amax) >> 23) & 255u;
  int sb = (int)e - 2; if (sb < 1) sb = 1; if (sb > 254) sb = 254;
  return (unsigned)sb;
}
#ifdef EMU
__device__ __forceinline__ unsigned p6_enc1(float x) {
  const unsigned sgn = x < 0.f ? 32u : 0u; float a = fabsf(x);
  if (!(a == a)) a = 0.f;
  if (a >= 7.5f) return sgn | 31u;
  if (a < 1.f) { int m = (int)nearbyintf(a * 8.f); return sgn | (unsigned)m; }
  int e = a < 2.f ? 1 : a < 4.f ? 2 : 3;
  const float base = (float)(1 << (e - 1)), step = base / 8.f;
  int m = (int)nearbyintf((a - base) / step);
  unsigned code = (unsigned)(e * 8 + m);
  if (code > 31u) code = 31u;
  return sgn | code;
}
__device__ __forceinline__ float p6_dec1(unsigned c) {
  const unsigned e = (c >> 3) & 3u, m = c & 7u;
  const float v = e == 0 ? (float)m * 0.125f : (1.f + (float)m * 0.125f) * (float)(1 << (e - 1));
  return (c & 32u) ? -v : v;
}
__device__ __forceinline__ u32x6 p6_encode32(const float* x, float scale) {
  unsigned long long lo = 0, mid = 0, hi = 0;
  u32x6 r = (u32x6){0, 0, 0, 0, 0, 0};
  for (int i = 0; i < 32; ++i) { const unsigned c = p6_enc1(x[i] / scale); const int bit = i * 6; r[bit / 32] |= c << (bit % 32); if (bit % 32 > 26) r[bit / 32 + 1] |= c >> (32 - bit % 32); }
  (void)lo; (void)mid; (void)hi;
  return r;
}
__device__ __forceinline__ void p6_decode32(u32x6 w, float scale, float* o) {
  for (int i = 0; i < 32; ++i) { const int bit = i * 6; unsigned c = w[bit / 32] >> (bit % 32); if (bit % 32 > 26) c |= w[bit / 32 + 1] << (32 - bit % 32); o[i] = p6_dec1(c & 63u) * scale; }
}
#else
__device__ __forceinline__ u32x6 p6_encode32(const float* x, float scale) {
  f32x16 a, b;
#pragma unroll
  for (int i = 0; i < 16; ++i) { a[i] = x[2 * i]; b[i] = x[2 * i + 1]; }
  return __builtin_amdgcn_cvt_scalef32_2xpk16_fp6_f32(a, b, scale);
}
__device__ __forceinline__ void p6_decode32(u32x6 w, float scale, float* o) {
  const f32x32 r = __builtin_amdgcn_cvt_scalef32_pk32_f32_fp6(w, scale);
#pragma unroll
  for (int i = 0; i < 32; ++i) o[i] = r[i];
}
#endif
__device__ __forceinline__ void task_convert_fp6(const float* src, unsigned char* dst, int nrows, int unit, int nunits) {
  const size_t nblk = (size_t)nrows * P6_NB;
  for (size_t i = (size_t)unit * NTHR + TIDX; i < nblk; i += (size_t)nunits * NTHR) {
    const size_t row = i / P6_NB; const int blk = (int)(i % P6_NB);
    const float* sp = src + row * D + blk * 32;
    float x[32]; float amax = 0.f;
#pragma unroll
    for (int q = 0; q < 8; ++q) {
      const float4 v = *(const float4*)(sp + q * 4);
      x[q * 4] = v.x; x[q * 4 + 1] = v.y; x[q * 4 + 2] = v.z; x[q * 4 + 3] = v.w;
      amax = fmaxf(amax, fmaxf(fmaxf(fabsf(v.x), fabsf(v.y)), fmaxf(fabsf(v.z), fabsf(v.w))));
    }
    const unsigned sb = p6_scale_byte(amax);
    const u32x6 w = p6_encode32(x, p6_scale_from_byte(sb));
    unsigned char* rp = dst + row * P6_ROWB;
    unsigned* wp = (unsigned*)(rp + blk * 24);
#pragma unroll
    for (int q = 0; q < 6; ++q) wp[q] = w[q];
    rp[P6_NB * 24 + blk] = (unsigned char)sb;
  }
}
constexpr int U_MOD = 2 * D6 / 64;
static_assert(D6 % 64 == 0 && D % 8 == 0, "mod units");
constexpr int U_TAB = ((SEQ + CTX_LEN) * 64 + SEQ / 2 + NTHR - 1) / NTHR;
constexpr int U_H3 = (SEQ + CTX_LEN) / 8;
constexpr int U_CONV = 2048;

__device__ __forceinline__ void convert_layer_weights(const Params& P, int layer, char* smem) {
  const float* win = layer == 0 ? P.ev_w_in : P.od_w_in;
  const int nin = layer == 0 ? EVEN_IN : ODD_IN;
  const int npin = layer == 0 ? NP_EV : NP_OD;
  const float* wout = layer == 0 ? P.ev_w_out : P.od_w_out;
  const float* wq = P.peer_wq + (size_t)layer * D * QW;
  const int u_in = (D / 64) * (npin / 64), u_out = (D / 64) * (D / 64), u_q = (D / 64) * (QW / 64);
  const int total = u_in + u_out + u_q + 2 * U_CONV + 8;
  for (int u = blockIdx.x; u < total; u += gridDim.x) {
    int v = u;
    if (v < u_in) { task_transpose(win, (h16*)(P.ws + O_WIN), D, nin, v, smem); continue; }
    v -= u_in;
    if (v < u_out) { task_transpose(wout, (h16*)(P.ws + O_WOUT), D, D, v, smem); continue; }
    v -= u_out;
    if (v < u_q) { task_transpose(wq, (h16*)(P.ws + O_WQ), D, QW, v, smem); continue; }
    v -= u_q;
    if (v < U_CONV) { task_convert_fp6(P.peer_u + (size_t)layer * PEER_E * D, (unsigned char*)(P.ws + O_TABU), PEER_E, v, U_CONV); continue; }
    v -= U_CONV;
    if (v < U_CONV) { task_convert_fp6(P.peer_v + (size_t)layer * PEER_E * D, (unsigned char*)(P.ws + O_TABV), PEER_E, v, U_CONV); continue; }
    v -= U_CONV;
    task_convert(P.peer_keys + (size_t)layer * PEER_H * 2 * PEER_KEYS * 128, (h16*)(P.ws + O_KEYS16), (size_t)PEER_H * 2 * PEER_KEYS * 128, v, 8);
  }
  if (layer == 1) {
    h16* lw = (h16*)(P.ws + O_LW16);
    for (size_t i = (size_t)blockIdx.x * NTHR + TIDX; i < (size_t)2 * LRU_BLOCKS * 2 * 64 * 64; i += (size_t)gridDim.x * NTHR) {
      const int ii = (int)(i % 64), j = (int)((i / 64) % 64), m = (int)((i / 4096) % 2), db = (int)(i / 8192);
      const float* src = (m == 0 ? P.lru_wa : P.lru_wx) + (size_t)db * 64 * 64;
      lw[i] = (h16)src[ii * 64 + j];
    }
    h16* rw = (h16*)(P.ws + O_RW16);
    for (size_t i = (size_t)blockIdx.x * NTHR + TIDX; i < (size_t)2 * 2 * RWW * 64; i += (size_t)gridDim.x * NTHR) {
      const int k = (int)(i % 64), nn = (int)((i / 64) % RWW), m = (int)((i / (64 * (size_t)RWW)) % 2), d = (int)(i / (2 * 64 * (size_t)RWW));
      const float* src = (m == 0 ? P.rw_w2 : P.rw_a2) + (size_t)d * 64 * RWW;
      rw[i] = (h16)src[(size_t)k * RWW + nn];
    }
    h16* g2t = (h16*)(P.ws + O_G216);
    for (size_t i = (size_t)blockIdx.x * NTHR + TIDX; i < (size_t)RWW * 160; i += (size_t)gridDim.x * NTHR) {
      const int k = (int)(i % 160), nn = (int)(i / 160);
      g2t[i] = (h16)P.rw_g2[(size_t)k * RWW + nn];
    }
  }
}

__device__ __forceinline__ void ph_prologue(const Params& P, char* smem) {
  const int total = U_MOD + U_TAB + U_H3;
  for (int u = blockIdx.x; u < total; u += gridDim.x) {
    int v = u;
    if (v < U_MOD) { task_mod(P, v, smem); continue; }
    v -= U_MOD;
    if (v < U_TAB) { task_tables(P, v); continue; }
    v -= U_TAB;
    task_h3(P, v, smem);
  }
  convert_layer_weights(P, 0, smem);
}

__device__ __forceinline__ void ph_modulate0(const Params& P) {
  h16* A = (h16*)(P.ws + O_ABUF);
  const size_t n4 = (size_t)NT * D / 4;
  for (size_t i = (size_t)blockIdx.x * NTHR + TIDX; i < n4; i += (size_t)gridDim.x * NTHR) {
    const size_t e = i * 4;
    const int row = (int)(e / D), k = (int)(e % D);
    const float* src = row < NL ? P.x + (size_t)row * D : P.ctx + (size_t)(row - NL) * D;
    const float4 v = *(const float4*)(src + k);
    const float* sh = mod_ptr(P, 0, row, 0) + k;
    const float* sc = mod_ptr(P, 0, row, 1) + k;
    h16x4 o;
    o[0] = (h16)(v.x * (1.f + sc[0]) + sh[0]); o[1] = (h16)(v.y * (1.f + sc[1]) + sh[1]);
    o[2] = (h16)(v.z * (1.f + sc[2]) + sh[2]); o[3] = (h16)(v.w * (1.f + sc[3]) + sh[3]);
    *(h16x4*)(A + e) = o;
  }
}

__device__ __forceinline__ void ph_filter(const Params& P, char* smem) {
  float* h3s = (float*)smem;
  float* w4s = h3s + 64 * 65;
  const float* h3 = (const float*)(P.ws + O_H3);
  h16* filt = (h16*)(P.ws + O_FILT);
  float* filtc = (float*)(P.ws + O_FILTC);
  constexpr int NTT = (SEQ + CTX_LEN) / 64, NCT = HY_CH / 64;
  const float max_decay = logf(1e-2f) / 0.3f, min_decay = logf(1e-2f) / 1.5f;
  for (int u = blockIdx.x; u < NTT * NCT; u += gridDim.x) {
    const int tt = u % NTT, ct = u / NTT;
    const int gp0 = tt * 64, c0 = ct * 64;
    const bool isc = gp0 >= SEQ;
    const int L = isc ? CTX_LEN : SEQ;
    const int t0 = isc ? gp0 - SEQ : gp0;
    __syncthreads();
    for (int i = TIDX; i < 64 * 64; i += NTHR) { int t = i / 64, j = i % 64; h3s[t * 65 + j] = h3[(size_t)(gp0 + t) * FH + j]; }
    for (int i = TIDX; i < 64 * 128; i += NTHR) {
      int j = i / 128, col = i % 128, cc = col / 2, dir = col % 2;
      w4s[j * 128 + col] = P.f_w4[(size_t)j * (2 * HY_CH) + dir * HY_CH + c0 + cc];
    }
    __syncthreads();
    const int t = TIDX % 64, cg = TIDX / 64;
    float acc[16];
#pragma unroll
    for (int q = 0; q < 16; ++q) acc[q] = 0.f;
    for (int j = 0; j < 64; ++j) {
      const float h = h3s[t * 65 + j];
#pragma unroll
      for (int q = 0; q < 16; ++q) acc[q] += h * w4s[j * 128 + cg * 16 + q];
    }
    const float tn = (float)(t0 + t) / (float)(L - 1);
#pragma unroll
    for (int q = 0; q < 16; ++q) {
      const int col = cg * 16 + q, cc = col / 2, dir = col % 2, c = c0 + cc;
      const float delta = fabsf(min_decay + (max_decay - min_decay) * (float)c / (float)(HY_CH - 1));
      const float v = (acc[q] + P.f_b4[dir * HY_CH + c]) * expf(-tn * delta);
      if (isc) filtc[((size_t)c * 2 + dir) * CTX_LEN + t0 + t] = v;
      else filt[((size_t)c * 2 + dir) * SEQ + t0 + t] = (h16)v;
    }
  }
}

__device__ __forceinline__ float hy_short(const Params& P, const h16* p, int rbase, int L, int t, int col) {
  float acc = P.hy_short_b[col];
#pragma unroll
  for (int k = 0; k < 3; ++k) {
    int tt = t + k - 1;
    if (tt >= 0 && tt < L) acc += P.hy_short_w[k * (3 * HY_CH) + col] * (float)p[(size_t)(rbase + tt) * NP_EV + col];
  }
  return acc;
}

__device__ __forceinline__ void hy_short8(const Params& P, const h16* p, int rbase, int L, int t, int col0, float* out) {
  const float4 b0 = *(const float4*)(P.hy_short_b + col0), b1 = *(const float4*)(P.hy_short_b + col0 + 4);
  out[0] = b0.x; out[1] = b0.y; out[2] = b0.z; out[3] = b0.w; out[4] = b1.x; out[5] = b1.y; out[6] = b1.z; out[7] = b1.w;
#pragma unroll
  for (int k = 0; k < 3; ++k) {
    const int tt = t + k - 1;
    if (tt >= 0 && tt < L) {
      const h16x8 pv = *(const h16x8*)(p + (size_t)(rbase + tt) * NP_EV + col0);
      const float4 w0 = *(const float4*)(P.hy_short_w + k * (3 * HY_CH) + col0), w1 = *(const float4*)(P.hy_short_w + k * (3 * HY_CH) + col0 + 4);
      out[0] += w0.x * (float)pv[0]; out[1] += w0.y * (float)pv[1]; out[2] += w0.z * (float)pv[2]; out[3] += w0.w * (float)pv[3];
      out[4] += w1.x * (float)pv[4]; out[5] += w1.y * (float)pv[5]; out[6] += w1.z * (float)pv[6]; out[7] += w1.w * (float)pv[7];
    }
  }
}

__device__ __forceinline__ void ph_hyena_pre(const Params& P, char* smem) {
  float* zs = (float*)smem;
  const h16* p = (const h16*)(P.ws + O_P0);
  h16* zT = (h16*)P.out;
  constexpr int NTT = SEQ / 64, NCT = HY_CH / 64;
  for (int u = blockIdx.x; u < BATCH * NTT * NCT; u += gridDim.x) {
    const int ct = u % NCT, tt = (u / NCT) % NTT, b = u / (NCT * NTT);
    const int t0 = tt * 64, c0 = ct * 64;
    __syncthreads();
    {
      const int i = TIDX, t = i / 8, c8 = (i % 8) * 8;
      float x1[8], v[8];
      hy_short8(P, p, b * SEQ, SEQ, t0 + t, HY_CH + c0 + c8, x1);
      hy_short8(P, p, b * SEQ, SEQ, t0 + t, 2 * HY_CH + c0 + c8, v);
#pragma unroll
      for (int j = 0; j < 8; ++j) zs[t * 65 + c8 + j] = x1[j] * v[j];
    }
    __syncthreads();
#pragma unroll 4
    for (int i = TIDX; i < 64 * 64; i += NTHR) {
      int c = i / 64, t = i % 64;
      zT[((size_t)(c0 + c) * BATCH + b) * SEQ + t0 + t] = (h16)zs[t * 65 + c];
    }
  }
}

__device__ __forceinline__ float2 cmul_(float2 a, float2 w) { return make_float2(a.x * w.x - a.y * w.y, a.x * w.y + a.y * w.x); }
__device__ __forceinline__ float2 cmulc_(float2 a, float2 w) { return make_float2(a.x * w.x + a.y * w.y, a.y * w.x - a.x * w.y); }
constexpr int FFT_LOG = __builtin_ctz(SEQ);
__device__ __forceinline__ void fft_r2(float2* X, const float2* tw, int lh, bool inv) {
  const int h = 1 << lh, tsh = (FFT_LOG - 1) - lh;
  __syncthreads();
#pragma unroll 4
  for (int m = TIDX; m < SEQ / 2; m += NTHR) {
    const int j = m & (h - 1), i = ((m >> lh) << (lh + 1)) + j;
    const float2 a = X[i], b = X[i + h], w = tw[j << tsh];
    if (!inv) { X[i] = make_float2(a.x + b.x, a.y + b.y); X[i + h] = cmul_(make_float2(a.x - b.x, a.y - b.y), w); }
    else { const float2 bw = cmulc_(b, w); X[i] = make_float2(a.x + bw.x, a.y + bw.y); X[i + h] = make_float2(a.x - bw.x, a.y - bw.y); }
  }
}
__device__ __forceinline__ void fft_fwd(float2* X, const float2* tw) {
  int lh = FFT_LOG - 1;
  if (FFT_LOG & 1) { fft_r2(X, tw, lh, false); --lh; }
  for (; lh >= 1; lh -= 2) {
    const int lq = lh - 1, q = 1 << lq;
    const int tsh = (FFT_LOG - 2) - lq;
    __syncthreads();
#pragma unroll 2
    for (int m = TIDX; m < SEQ / 4; m += NTHR) {
      const int j = m & (q - 1), i = ((m >> lq) << (lq + 2)) + j;
      const float2 x0 = X[i], x1 = X[i + q], x2 = X[i + 2 * q], x3 = X[i + 3 * q];
      const float2 w1 = tw[j << tsh], w2 = tw[(2 * j) << tsh];
      const float2 a = make_float2(x0.x + x2.x, x0.y + x2.y), bq = make_float2(x0.x - x2.x, x0.y - x2.y);
      const float2 c = make_float2(x1.x + x3.x, x1.y + x3.y), d = make_float2(x1.y - x3.y, -(x1.x - x3.x));
      X[i] = make_float2(a.x + c.x, a.y + c.y);
      X[i + q] = cmul_(make_float2(a.x - c.x, a.y - c.y), w2);
      X[i + 2 * q] = cmul_(make_float2(bq.x + d.x, bq.y + d.y), w1);
      X[i + 3 * q] = cmul_(make_float2(bq.x - d.x, bq.y - d.y), cmul_(w1, w2));
    }
  }
  __syncthreads();
}
__device__ __forceinline__ void fft_inv(float2* X, const float2* tw) {
  int lq = 0;
  for (; lq + 1 <= FFT_LOG - 1; lq += 2) {
    const int q = 1 << lq;
    const int tsh = (FFT_LOG - 2) - lq;
    __syncthreads();
#pragma unroll 2
    for (int m = TIDX; m < SEQ / 4; m += NTHR) {
      const int j = m & (q - 1), i = ((m >> lq) << (lq + 2)) + j;
      const float2 x0 = X[i], x1 = X[i + q], x2 = X[i + 2 * q], x3 = X[i + 3 * q];
      const float2 w1 = tw[j << tsh], w2 = tw[(2 * j) << tsh];
      const float2 t1 = cmulc_(x1, w2), t3 = cmulc_(x3, w2);
      const float2 p0 = make_float2(x0.x + t1.x, x0.y + t1.y), p1 = make_float2(x0.x - t1.x, x0.y - t1.y);
      const float2 p2 = cmulc_(make_float2(x2.x + t3.x, x2.y + t3.y), w1), p3w = cmulc_(make_float2(x2.x - t3.x, x2.y - t3.y), w1);
      const float2 p3 = make_float2(-p3w.y, p3w.x);
      X[i] = make_float2(p0.x + p2.x, p0.y + p2.y);
      X[i + 2 * q] = make_float2(p0.x - p2.x, p0.y - p2.y);
      X[i + q] = make_float2(p1.x + p3.x, p1.y + p3.y);
      X[i + 3 * q] = make_float2(p1.x - p3.x, p1.y - p3.y);
    }
  }
  if (FFT_LOG & 1) fft_r2(X, tw, FFT_LOG - 1, true);
  __syncthreads();
}

__device__ __forceinline__ void ph_hyena_fft(const Params& P, char* smem) {
  float2* X = (float2*)smem;
  const float2* tw = (const float2*)(P.ws + O_TW);
  const h16* filt = (const h16*)(P.ws + O_FILT);
  float2* scr = (float2*)(P.ws + O_FFTS) + (size_t)blockIdx.x * 2 * SEQ;
  h16* zT = (h16*)P.out;
  constexpr int L = SEQ;
  for (int c = blockIdx.x; c < HY_CH; c += gridDim.x) {
    const h16* g0 = filt + ((size_t)c * 2 + 0) * L;
    const h16* g1 = filt + ((size_t)c * 2 + 1) * L;
    h16* z0 = zT + ((size_t)c * BATCH + 0) * L;
    h16* z1 = zT + ((size_t)c * BATCH + 1) * L;
    __syncthreads();
    for (int n = TIDX; n < L; n += NTHR) {
      const float gb = n == 0 ? 0.f : (float)g1[L - n];
      X[n] = make_float2((float)g0[n] + gb, 0.f);
    }
    fft_fwd(X, tw);
    for (int n = TIDX; n < L; n += NTHR) scr[n] = X[n];
    __syncthreads();
    for (int n = TIDX; n < L; n += NTHR) {
      const float gb = n == 0 ? 0.f : (float)g1[L - n];
      float s, co; sincospif(-(float)n / (float)L, &s, &co);
      const float d = (float)g0[n] - gb;
      X[n] = make_float2(d * co, d * s);
    }
    fft_fwd(X, tw);
    for (int n = TIDX; n < L; n += NTHR) scr[L + n] = X[n];
    __syncthreads();
    for (int n = TIDX; n < L; n += NTHR) X[n] = make_float2((float)z0[n], (float)z1[n]);
    fft_fwd(X, tw);
    for (int n = TIDX; n < L; n += NTHR) {
      const float2 a = X[n], f = scr[n];
      X[n] = make_float2(a.x * f.x - a.y * f.y, a.x * f.y + a.y * f.x);
    }
    fft_inv(X, tw);
    for (int n = TIDX; n < L; n += NTHR) scr[n] = X[n];
    __syncthreads();
    for (int n = TIDX; n < L; n += NTHR) {
      float s, co; sincospif(-(float)n / (float)L, &s, &co);
      const float ax = (float)z0[n], ay = (float)z1[n];
      X[n] = make_float2(ax * co - ay * s, ax * s + ay * co);
    }
    fft_fwd(X, tw);
    for (int n = TIDX; n < L; n += NTHR) {
      const float2 a = X[n], f = scr[L + n];
      X[n] = make_float2(a.x * f.x - a.y * f.y, a.x * f.y + a.y * f.x);
    }
    fft_inv(X, tw);
    const float sc = 0.5f / (float)L;
    for (int n = TIDX; n < L; n += NTHR) {
      float s, co; sincospif((float)n / (float)L, &s, &co);
      const float2 o = X[n], e = scr[n];
      const float yx = e.x + (o.x * co - o.y * s), yy = e.y + (o.x * s + o.y * co);
      z0[n] = (h16)(yx * sc); z1[n] = (h16)(yy * sc);
    }
  }
}

__device__ __forceinline__ void ph_hyena_post(const Params& P, char* smem) {
  const h16* p = (const h16*)(P.ws + O_P0);
  h16* mix = (h16*)(P.ws + O_ABUF);
  const h16* zT = (const h16*)P.out;
  constexpr int NTT = SEQ / 64, NCT = HY_CH / 64;
  constexpr int U_LAT = BATCH * NTT * NCT;
  constexpr int CT_ = 8;
  constexpr int U_CTX = BATCH * (HY_CH / CT_);
  for (int u = blockIdx.x; u < U_LAT + U_CTX; u += gridDim.x) {
    __syncthreads();
    if (u < U_LAT) {
      float* cs = (float*)smem;
      const int ct = u % NCT, tt = (u / NCT) % NTT, b = u / (NCT * NTT);
      const int t0 = tt * 64, c0 = ct * 64;
#pragma unroll 4
      for (int i = TIDX; i < 64 * 64; i += NTHR) {
        int c = i / 64, t = i % 64;
        cs[t * 65 + c] = (float)zT[((size_t)(c0 + c) * BATCH + b) * SEQ + t0 + t];
      }
      __syncthreads();
      {
        const int i = TIDX, t = i / 8, c8 = (i % 8) * 8;
        float x0[8], x1[8], v[8];
        hy_short8(P, p, b * SEQ, SEQ, t0 + t, c0 + c8, x0);
        hy_short8(P, p, b * SEQ, SEQ, t0 + t, HY_CH + c0 + c8, x1);
        hy_short8(P, p, b * SEQ, SEQ, t0 + t, 2 * HY_CH + c0 + c8, v);
        const float4 hb0 = *(const float4*)(P.hy_bias + c0 + c8), hb1 = *(const float4*)(P.hy_bias + c0 + c8 + 4);
        const float hb[8] = {hb0.x, hb0.y, hb0.z, hb0.w, hb1.x, hb1.y, hb1.z, hb1.w};
        h16x8 o;
#pragma unroll
        for (int j = 0; j < 8; ++j) o[j] = (h16)(x0[j] * (cs[t * 65 + c8 + j] + x1[j] * v[j] * hb[j]));
        *(h16x8*)(mix + (size_t)(b * SEQ + t0 + t) * D + c0 + c8) = o;
      }
    } else {
      const int v_ = u - U_LAT;
      const int ct = v_ % (HY_CH / CT_), b = v_ / (HY_CH / CT_);
      const int c0 = ct * CT_;
      float* zs = (float*)smem;
      constexpr int GLD = CTX_LEN + 1;
      float* gs = zs + CTX_LEN * (CT_ + 1);
      const float* filtc = (const float*)(P.ws + O_FILTC);
      const int rbase = NL + b * CTX_LEN;
#pragma unroll 4
      for (int i = TIDX; i < CTX_LEN * CT_; i += NTHR) {
        int t = i / CT_, c = i % CT_;
        float x1 = hy_short(P, p, rbase, CTX_LEN, t, HY_CH + c0 + c);
        float v = hy_short(P, p, rbase, CTX_LEN, t, 2 * HY_CH + c0 + c);
        zs[t * (CT_ + 1) + c] = x1 * v;
      }
      for (int i = TIDX; i < CT_ * 2 * CTX_LEN; i += NTHR) gs[(i / CTX_LEN) * GLD + i % CTX_LEN] = filtc[(size_t)c0 * 2 * CTX_LEN + i];
      __syncthreads();
      for (int i = TIDX; i < CTX_LEN * CT_; i += NTHR) {
        int t = i / CT_, c = i % CT_;
        float acc = 0.f;
        for (int s = 0; s < CTX_LEN; ++s) {
          int d = t - s;
          float g = d >= 0 ? gs[(c * 2 + 0) * GLD + d] : gs[(c * 2 + 1) * GLD - d];
          acc += zs[s * (CT_ + 1) + c] * g;
        }
        float x0 = hy_short(P, p, rbase, CTX_LEN, t, c0 + c);
        mix[(size_t)(rbase + t) * D + c0 + c] = (h16)(x0 * (acc + zs[t * (CT_ + 1) + c] * P.hy_bias[c0 + c]));
      }
    }
  }
}

__device__ __forceinline__ float ret_lg(int h, int dir) {
  int hh = dir == 0 ? h : RET_HEADS - 1 - h;
  return log1pf(-exp2f(-5.0f - (float)hh));
}
__device__ __forceinline__ int ret_chunk_row(int b, int n) {
  return n < RET_LCH ? b * SEQ + n * RET_C : NL + b * CTX_LEN + (n - RET_LCH) * RET_C;
}
__device__ __forceinline__ void ph_rope(const Params& P) {
  h16* p = (h16*)(P.ws + O_P0);
  const float* rc = (const float*)(P.ws + O_ROPE);
  const float* rs = rc + (size_t)(SEQ + CTX_LEN) * 64;
  const float kscale = 0.08838834764831845f;
  constexpr int PER_ROW = 2 * RET_HEADS * 16;
  const size_t total = (size_t)NT * PER_ROW;
#pragma unroll 2
  for (size_t i = (size_t)blockIdx.x * NTHR + TIDX; i < total; i += (size_t)gridDim.x * NTHR) {
    const int row = (int)(i / PER_ROW), it = (int)(i % PER_ROW);
    const int f4 = it % 16, hh = (it / 16) % RET_HEADS, qk = it / (16 * RET_HEADS);
    int isc, b, t; row_decode(row, isc, b, t);
    const int pos = isc ? SEQ + t : t;
    h16* pr = p + (size_t)row * NP_EV + 3 * HY_CH + qk * RETW + hh * RET_HD + f4 * 4;
    const h16x4 t1 = *(const h16x4*)pr, t2 = *(const h16x4*)(pr + 64);
    const float4 c = *(const float4*)(rc + (size_t)pos * 64 + f4 * 4), s = *(const float4*)(rs + (size_t)pos * 64 + f4 * 4);
    const float sc = qk ? kscale : 1.0f;
    h16x4 o1, o2;
    o1[0] = (h16)(((float)t1[0] * c.x - (float)t2[0] * s.x) * sc); o2[0] = (h16)(((float)t1[0] * s.x + (float)t2[0] * c.x) * sc);
    o1[1] = (h16)(((float)t1[1] * c.y - (float)t2[1] * s.y) * sc); o2[1] = (h16)(((float)t1[1] * s.y + (float)t2[1] * c.y) * sc);
    o1[2] = (h16)(((float)t1[2] * c.z - (float)t2[2] * s.z) * sc); o2[2] = (h16)(((float)t1[2] * s.z + (float)t2[2] * c.z) * sc);
    o1[3] = (h16)(((float)t1[3] * c.w - (float)t2[3] * s.w) * sc); o2[3] = (h16)(((float)t1[3] * s.w + (float)t2[3] * c.w) * sc);
    *(h16x4*)pr = o1; *(h16x4*)(pr + 64) = o2;
  }
}
__device__ __forceinline__ void ret_copy_tile(const h16* src, h16* dst, int ntok) {
#pragma unroll 4
  for (int i = TIDX; i < ntok * 16; i += NTHR) {
    const int t = i / 16, c8 = i % 16;
    *(h16x8*)(dst + t * 136 + c8 * 8) = *(const h16x8*)(src + (size_t)t * NP_EV + c8 * 8);
  }
}
__device__ __forceinline__ h16x8 frag_rows(const h16* tile, int ld, int row0, int col) {
  h16x8 f;
#pragma unroll
  for (int j = 0; j < 8; ++j) f[j] = tile[(row0 + j) * ld + col];
  return f;
}

__device__ __forceinline__ void ph_ret_inter(const Params& P, char* smem) {
  constexpr int LDR = 136;
  h16* Qs = (h16*)smem;
  h16* Ks = Qs + 128 * LDR;
  h16* Vs = Ks + 128 * LDR;
  h16* St = Vs + 128 * 24;
  float* dec = (float*)(St + 2 * 16 * LDR);
  float* wk = dec + 128;
  const h16* p = (const h16*)(P.ws + O_P0);
  h16* yint = (h16*)P.out;
  constexpr int NU = BATCH * RET_HEADS * 2 * 8;
  const int tid = TIDX, wave = tid >> 6, lane = tid & 63;
  for (int u = blockIdx.x; u < NU; u += gridDim.x) {
    const int dvs = u % 8, dir = (u / 8) % 2, h = (u / 16) % RET_HEADS, b = u / (16 * RET_HEADS);
    const float lg = ret_lg(h, dir);
    const float gC = expf(lg * (float)RET_C);
    __syncthreads();
    if (tid < 128) {
      dec[tid] = dir == 0 ? expf(lg * (float)(tid + 1)) : expf(lg * (float)(RET_C - tid));
      wk[tid] = dir == 0 ? expf(lg * (float)(RET_C - 1 - tid)) : expf(lg * (float)tid);
    }
    for (int i = tid; i < 2 * 16 * LDR; i += NTHR) St[i] = (h16)0.f;
    f32x4 accS = (f32x4){0.f, 0.f, 0.f, 0.f};
    auto chunk_of = [&](int o) -> int {
      if (o < RET_CCH) return RET_LCH + (dir == 0 ? o : RET_CCH - 1 - o);
      return dir == 0 ? (o - RET_CCH) : (RET_LCH - 1 - (o - RET_CCH));
    };
    h16x8 rq[4], rk[4], rv;
#define RI_FETCH(o_) do { const h16* pq_ = p + (size_t)ret_chunk_row(b, chunk_of(o_)) * NP_EV + 3 * HY_CH + h * RET_HD; \
      _Pragma("unroll") for (int k_ = 0; k_ < 4; ++k_) { const int i_ = tid + k_ * NTHR, t_ = i_ / 16, c8_ = i_ % 16; \
        rq[k_] = *(const h16x8*)(pq_ + (size_t)t_ * NP_EV + c8_ * 8); rk[k_] = *(const h16x8*)(pq_ + RETW + (size_t)t_ * NP_EV + c8_ * 8); } \
      if (tid < 256) rv = *(const h16x8*)(pq_ + (size_t)(tid / 2) * NP_EV + 2 * RETW + dvs * 16 + (tid % 2) * 8); } while (0)
    RI_FETCH(0);
    for (int o = 0; o < RET_NCH; ++o) {
      const int row0 = ret_chunk_row(b, chunk_of(o));
      const h16* Scur = St + (o & 1) * 16 * LDR;
      h16* Snxt = St + ((o + 1) & 1) * 16 * LDR;
      __syncthreads();
#pragma unroll
      for (int k_ = 0; k_ < 4; ++k_) {
        const int i_ = tid + k_ * NTHR, t_ = i_ / 16, c8_ = i_ % 16;
        *(h16x8*)(Qs + t_ * LDR + c8_ * 8) = rq[k_]; *(h16x8*)(Ks + t_ * LDR + c8_ * 8) = rk[k_];
      }
      if (tid < 256) {
        const int t_ = tid / 2; const float w = wk[t_];
        h16x8 o8;
#pragma unroll
        for (int j = 0; j < 8; ++j) o8[j] = (h16)(w * (float)rv[j]);
        *(h16x8*)(Vs + t_ * 24 + (tid % 2) * 8) = o8;
      }
      if (o + 1 < RET_NCH) RI_FETCH(o + 1);
      __syncthreads();
      f32x4 accY = (f32x4){0.f, 0.f, 0.f, 0.f};
      f32x4 accU = (f32x4){0.f, 0.f, 0.f, 0.f};
#pragma unroll
      for (int ks = 0; ks < 4; ++ks) {
        const int ko = ks * 32 + (lane >> 4) * 8;
        const h16x8 aq = *(const h16x8*)(Qs + (wave * 16 + (lane & 15)) * LDR + ko);
        const h16x8 bs = *(const h16x8*)(Scur + (lane & 15) * LDR + ko);
        accY = MFMA16(aq, bs, accY);
        const h16x8 ak = frag_rows(Ks, LDR, ko, wave * 16 + (lane & 15));
        const h16x8 bv = frag_rows(Vs, 24, ko, lane & 15);
        accU = MFMA16(ak, bv, accU);
      }
      h16x4 sv;
#pragma unroll
      for (int i = 0; i < 4; ++i) {
        const int j = wave * 16 + (lane >> 4) * 4 + i;
        yint[((size_t)dir * NT + row0 + j) * RETW + h * RET_HD + dvs * 16 + (lane & 15)] = (h16)(accY[i] * dec[j]);
        accS[i] = gC * accS[i] + accU[i];
        sv[i] = (h16)accS[i];
      }
      *(h16x4*)(Snxt + (lane & 15) * LDR + wave * 16 + (lane >> 4) * 4) = sv;
    }
#undef RI_FETCH
  }
}

__device__ __forceinline__ void ph_ret_out(const Params& P, char* smem) {
  constexpr int LDR = 136;
  h16* Qs = (h16*)smem;
  h16* Ks = Qs + 128 * LDR;
  h16* Vs = Ks + 128 * LDR;
  float* pf = (float*)(Vs + 128 * LDR);
  const h16* p = (const h16*)(P.ws + O_P0);
  const h16* yint = (const h16*)P.out;
  h16* mix = (h16*)(P.ws + O_ABUF);
  constexpr int NU = BATCH * RET_HEADS * RET_NCH;
  const int tid = TIDX, wave = tid >> 6, lane = tid & 63;
  for (int u = blockIdx.x; u < NU; u += gridDim.x) {
    const int n = u % RET_NCH, h = (u / RET_NCH) % RET_HEADS, b = u / (RET_NCH * RET_HEADS);
    const int row0 = ret_chunk_row(b, n);
    const float lgf = ret_lg(h, 0), lgb = ret_lg(h, 1);
    const h16* pq = p + (size_t)row0 * NP_EV + 3 * HY_CH + h * RET_HD;
    __syncthreads();
    ret_copy_tile(pq, Qs, 128);
    ret_copy_tile(pq + RETW, Ks, 128);
    ret_copy_tile(pq + 2 * RETW, Vs, 128);
    if (tid < 128) {
      pf[tid] = expf(lgf * (float)tid); pf[128 + tid] = expf(-lgf * (float)tid);
      pf[256 + tid] = expf(lgb * (float)tid); pf[384 + tid] = expf(-lgb * (float)tid);
    }
    __syncthreads();
    f32x4 acc[8];
#pragma unroll
    for (int mt = 0; mt < 8; ++mt) acc[mt] = (f32x4){0.f, 0.f, 0.f, 0.f};
#pragma unroll
    for (int ks = 0; ks < 4; ++ks) {
      const int ko = ks * 32 + (lane >> 4) * 8;
      const h16x8 aq = *(const h16x8*)(Qs + (wave * 16 + (lane & 15)) * LDR + ko);
#pragma unroll
      for (int mt = 0; mt < 8; ++mt) {
        const h16x8 bk = *(const h16x8*)(Ks + (mt * 16 + (lane & 15)) * LDR + ko);
        acc[mt] = MFMA16(aq, bk, acc[mt]);
      }
    }
#pragma unroll
    for (int mt = 0; mt < 8; ++mt) {
      const int m = mt * 16 + (lane & 15);
      const float cf = pf[128 + m], cb = pf[256 + m];
#pragma unroll
      for (int i = 0; i < 4; ++i) {
        const int qi = wave * 16 + (lane >> 4) * 4 + i;
        const float w = m <= qi ? pf[qi] * cf : cb * pf[384 + qi];
        Qs[qi * LDR + m] = (h16)(acc[mt][i] * w);
      }
    }
#ifdef EMU
    __syncthreads();
#endif
    f32x4 ya[8];
#pragma unroll
    for (int et = 0; et < 8; ++et) ya[et] = (f32x4){0.f, 0.f, 0.f, 0.f};
#pragma unroll
    for (int ks = 0; ks < 4; ++ks) {
      const int ko = ks * 32 + (lane >> 4) * 8;
      const h16x8 ap = *(const h16x8*)(Qs + (wave * 16 + (lane & 15)) * LDR + ko);
#pragma unroll
      for (int et = 0; et < 8; ++et) {
        const h16x8 bv = frag_rows(Vs, LDR, ko, et * 16 + (lane & 15));
        ya[et] = MFMA16(ap, bv, ya[et]);
      }
    }
#pragma unroll
    for (int i = 0; i < 4; ++i) {
      const int row = row0 + wave * 16 + (lane >> 4) * 4 + i;
      float s = 0.f;
#pragma unroll
      for (int et = 0; et < 8; ++et) {
        const int e = et * 16 + (lane & 15);
        ya[et][i] += (float)yint[((size_t)0 * NT + row) * RETW + h * RET_HD + e] + (float)yint[((size_t)1 * NT + row) * RETW + h * RET_HD + e];
        s += ya[et][i];
      }
      s = row_sum16(s);
      const float mu = s * (1.f / 128.f);
      float s2 = 0.f;
#pragma unroll
      for (int et = 0; et < 8; ++et) { const float d_ = ya[et][i] - mu; s2 += d_ * d_; }
      s2 = row_sum16(s2);
      const float rstd = rsqrtf(s2 * (1.f / 128.f) + RET_EPS);
#pragma unroll
      for (int et = 0; et < 8; ++et) {
        const int e = et * 16 + (lane & 15);
        const float g = (float)p[(size_t)row * NP_EV + 3 * HY_CH + 3 * RETW + h * RET_HD + e];
        mix[(size_t)row * D + HY_CH + h * RET_HD + e] = (h16)((ya[et][i] - mu) * rstd * siluf_(g));
      }
    }
  }
}

constexpr int LN_VW = (D >= 256) ? 4 : (D / 64);
constexpr int LN_NCH = D / (64 * LN_VW);
template <bool IN16, bool OUT16>
__device__ __forceinline__ void ph_ln1(const Params& P, int layer, const float* xlat, const float* xctx, float* olat, float* octx, const h16* Y, int nrows, char* smem) {
  (void)smem;
  h16* xq = (h16*)(P.ws + O_ABUF);
  const float* g = P.ln_g + (size_t)(layer * 2 + 0) * D;
  const float* bb = P.ln_b + (size_t)(layer * 2 + 0) * D;
  const int tid = TIDX, wave = tid >> 6, lane = tid & 63;
  for (int row = blockIdx.x * (NTHR / 64) + wave; row < nrows; row += gridDim.x * (NTHR / 64)) {
    const float* xs = (row < NL ? xlat + (size_t)row * D : xctx + (size_t)(row - NL) * D) + lane * LN_VW;
    float* xo = (row < NL ? olat + (size_t)row * D : octx + (size_t)(row - NL) * D) + lane * LN_VW;
    const h16* yp = Y + (size_t)row * D + lane * LN_VW;
    const float* gt = mod_ptr(P, layer, row, 2) + lane * LN_VW;
    const float* sh2 = mod_ptr(P, layer, row, 3) + lane * LN_VW;
    const float* sc2 = mod_ptr(P, layer, row, 4) + lane * LN_VW;
    float4 v[LN_NCH];
    float s = 0.f;
#pragma unroll
    for (int c = 0; c < LN_NCH; ++c) {
      float4 xa; const float4 ga = *(const float4*)(gt + c * 64 * LN_VW);
      if (IN16 && row < NL) { const h16x4 xh_ = *(const h16x4*)((const h16*)(xlat + (size_t)row * D) + lane * LN_VW + c * 64 * LN_VW); xa = make_float4((float)xh_[0], (float)xh_[1], (float)xh_[2], (float)xh_[3]); }
      else xa = *(const float4*)(xs + c * 64 * LN_VW);
      const h16x4 yh = *(const h16x4*)(yp + c * 64 * LN_VW);
      const float4 ya = make_float4((float)yh[0], (float)yh[1], (float)yh[2], (float)yh[3]);
      v[c].x = ALPHA * xa.x + ga.x * ya.x; v[c].y = ALPHA * xa.y + ga.y * ya.y; v[c].z = ALPHA * xa.z + ga.z * ya.z; v[c].w = ALPHA * xa.w + ga.w * ya.w;
      s += (v[c].x + v[c].y) + (v[c].z + v[c].w);
    }
    s = wave_sum(s);
    const float mu = s / (float)D;
    float s2 = 0.f;
#pragma unroll
    for (int c = 0; c < LN_NCH; ++c) {
      const float a = v[c].x - mu, b2 = v[c].y - mu, c2 = v[c].z - mu, d2 = v[c].w - mu;
      s2 += (a * a + b2 * b2) + (c2 * c2 + d2 * d2);
    }
    s2 = wave_sum(s2);
    const float rstd = rsqrtf(s2 / (float)D + LN_EPS);
#pragma unroll
    for (int c = 0; c < LN_NCH; ++c) {
      const int off = c * 64 * LN_VW;
      const float4 gv = *(const float4*)(g + lane * LN_VW + off), bv = *(const float4*)(bb + lane * LN_VW + off);
      const float4 sv = *(const float4*)(sc2 + off), hv = *(const float4*)(sh2 + off);
      float4 o;
      o.x = (v[c].x - mu) * rstd * gv.x + bv.x; o.y = (v[c].y - mu) * rstd * gv.y + bv.y;
      o.z = (v[c].z - mu) * rstd * gv.z + bv.z; o.w = (v[c].w - mu) * rstd * gv.w + bv.w;
      if (OUT16 && row < NL) { h16x4 oh_; oh_[0] = (h16)o.x; oh_[1] = (h16)o.y; oh_[2] = (h16)o.z; oh_[3] = (h16)o.w; *(h16x4*)((h16*)(olat + (size_t)row * D) + lane * LN_VW + off) = oh_; }
      else *(float4*)(xo + off) = o;
      h16x4 q;
      q[0] = (h16)(o.x * (1.f + sv.x) + hv.x); q[1] = (h16)(o.y * (1.f + sv.y) + hv.y);
      q[2] = (h16)(o.z * (1.f + sv.z) + hv.z); q[3] = (h16)(o.w * (1.f + sv.w) + hv.w);
      *(h16x4*)(xq + (size_t)row * D + lane * LN_VW + off) = q;
    }
  }
}
static_assert(D % NTHR == 0 || D < NTHR, "D vs block");

constexpr int SC_LD = PEER_KEYS + 4;
constexpr int SEL_QN = PEER_KEYS / 4;
static_assert(PEER_KEYS <= 128 && 64 * 264 * 2 <= 40960, "select LDS plan / 7-bit index");
__device__ __forceinline__ int cand_count(int a) { return (int)((0x1112347FULL >> (4 * a)) & 15ULL) + 1; }
__device__ __forceinline__ void ph_peer_select(const Params& P, int layer, const h16* Q, int nrows, char* smem) {
  constexpr int QLD = 264;
  float* sc = (float*)smem;
  char* r1 = (char*)(sc + 128 * SC_LD);
  h16* qs = (h16*)r1;
  unsigned* tqk = (unsigned*)r1;
  float* cd = (float*)r1;
  float* tv = cd + 64 * 52;
  int* tp = (int*)(tv + 64 * 16);
  float* ts = (float*)(r1 + 40960);
  unsigned char* ti = (unsigned char*)(ts + 16 * 128);
  int* cab = (int*)(ti + 16 * 128);
  const h16* keys = (const h16*)(P.ws + O_KEYS16);
  int* seli = (int*)(P.ws + O_SELI);
  float* selg = (float*)(P.ws + O_SELG);
  const int ntile = nrows / 64;
  (void)layer;
  const int tid = TIDX, wave = tid >> 6, lane = tid & 63;
  if (tid == 0) { int nc = 0; for (int a = 0; a < 16; ++a) for (int b = 0; b < cand_count(a); ++b) cab[nc++] = a * 16 + b; }
  for (int u = blockIdx.x; u < ntile * PEER_H; u += gridDim.x) {
    const int hh = u % PEER_H, tile = u / PEER_H, row0 = tile * 64;
    __syncthreads();
#pragma unroll 4
    for (int i = tid; i < 64 * 32; i += NTHR) {
      const int r = i / 32, c8 = i % 32;
      *(h16x8*)(qs + r * QLD + c8 * 8) = *(const h16x8*)(Q + (size_t)(row0 + r) * QW + hh * PEER_QD + c8 * 8);
    }
    __syncthreads();
    for (int pr = wave; pr < 2 * (PEER_KEYS / 16); pr += NTHR / 64) {
      const int p = pr / (PEER_KEYS / 16), ntl = pr % (PEER_KEYS / 16);
      h16x8 bf[4];
#pragma unroll
      for (int ks = 0; ks < 4; ++ks) bf[ks] = *(const h16x8*)(keys + ((size_t)(hh * 2 + p) * PEER_KEYS + ntl * 16 + (lane & 15)) * 128 + ks * 32 + (lane >> 4) * 8);
      f32x4 acc[4];
#pragma unroll
      for (int mt = 0; mt < 4; ++mt) acc[mt] = (f32x4){0.f, 0.f, 0.f, 0.f};
#pragma unroll
      for (int ks = 0; ks < 4; ++ks)
#pragma unroll
        for (int mt = 0; mt < 4; ++mt) {
          const h16x8 af = *(const h16x8*)(qs + (mt * 16 + (lane & 15)) * QLD + p * 128 + ks * 32 + (lane >> 4) * 8);
          acc[mt] = MFMA16(af, bf[ks], acc[mt]);
        }
#pragma unroll
      for (int mt = 0; mt < 4; ++mt)
#pragma unroll
        for (int i = 0; i < 4; ++i) sc[((mt * 16 + (lane >> 4) * 4 + i) * 2 + p) * SC_LD + ntl * 16 + (lane & 15)] = acc[mt][i];
    }
    __syncthreads();
    {
      const int qt = tid >> 7, list = tid & 127;
      const float* l = sc + list * SC_LD + qt * SEL_QN;
      unsigned key[SEL_QN];
#pragma unroll
      for (int n4 = 0; n4 < SEL_QN / 4; ++n4) {
        const float4 v = *(const float4*)(l + n4 * 4);
        const float vv[4] = {v.x, v.y, v.z, v.w};
#pragma unroll
        for (int e = 0; e < 4; ++e) {
          unsigned ub = __builtin_bit_cast(unsigned, vv[e]);
          ub = (ub & 0x80000000u) ? ~ub : (ub | 0x80000000u);
          key[n4 * 4 + e] = (ub & ~127u) | (unsigned)(127 - (qt * SEL_QN + n4 * 4 + e));
        }
      }
#pragma unroll
      for (int size = 2; size <= SEL_QN; size *= 2)
#pragma unroll
        for (int stride = size / 2; stride > 0; stride /= 2)
#pragma unroll
          for (int i = 0; i < SEL_QN; ++i) {
            const int j = i ^ stride;
            if (j > i) {
              const unsigned a_ = key[i], b_ = key[j];
              const bool desc = (i & size) == 0;
              const unsigned hi = a_ > b_ ? a_ : b_, lo = a_ > b_ ? b_ : a_;
              key[i] = desc ? hi : lo; key[j] = desc ? lo : hi;
            }
          }
#pragma unroll
      for (int k = 0; k < TOPK; ++k) tqk[(qt * 16 + k) * 128 + list] = k < SEL_QN ? key[k] : 0u;
    }
    __syncthreads();
#pragma unroll 1
    for (int round = 0; round < 2; ++round) {
      const int qt = tid >> 7, list = tid & 127;
      const bool active = round == 0 ? (qt == 0 || qt == 2) : (qt == 0);
      const int qa = qt, qb = round == 0 ? qt + 1 : 2;
      if (active) {
        unsigned c[TOPK];
#pragma unroll
        for (int k = 0; k < TOPK; ++k) {
          const unsigned a_ = tqk[(qa * 16 + k) * 128 + list], b_ = tqk[(qb * 16 + (TOPK - 1 - k)) * 128 + list];
          c[k] = a_ > b_ ? a_ : b_;
        }
#pragma unroll
        for (int stride = TOPK / 2; stride > 0; stride /= 2)
#pragma unroll
          for (int i = 0; i < TOPK; ++i) {
            const int j = i ^ stride;
            if (j > i) { const unsigned a_ = c[i], b_ = c[j]; c[i] = a_ > b_ ? a_ : b_; c[j] = a_ > b_ ? b_ : a_; }
          }
        if (round == 0) {
#pragma unroll
          for (int k = 0; k < TOPK; ++k) tqk[(qa * 16 + k) * 128 + list] = c[k];
        } else {
#pragma unroll
          for (int k = 0; k < TOPK; ++k) {
            const int idx = 127 - (int)(c[k] & 127u);
            ts[k * 128 + list] = sc[list * SC_LD + idx]; ti[k * 128 + list] = (unsigned char)idx;
          }
        }
      }
      __syncthreads();
    }
    for (int i = tid; i < 64 * 50; i += NTHR) {
      const int tok = i / 50, c = i % 50, ab = cab[c];
      cd[tok * 52 + c] = ts[(ab >> 4) * 128 + tok * 2] + ts[(ab & 15) * 128 + tok * 2 + 1];
    }
    __syncthreads();
    for (int i = tid; i < 64 * 50; i += NTHR) {
      const int tok = i / 50, c = i % 50;
      const float v = cd[tok * 52 + c];
      int rank = 0;
      for (int j = 0; j < 50; ++j) { const float o = cd[tok * 52 + j]; rank += (o > v || (o == v && j < c)) ? 1 : 0; }
      if (rank < TOPK) { tv[tok * 16 + rank] = v; tp[tok * 16 + rank] = c; }
    }
    __syncthreads();
    for (int i = tid; i < 64 * 16; i += NTHR) {
      const int tok = i / 16, k = i % 16;
      const float mx = tv[tok * 16];
      float den = 0.f;
#pragma unroll
      for (int j = 0; j < TOPK; ++j) den += __expf(tv[tok * 16 + j] - mx);
      const int ab = cab[tp[tok * 16 + k]];
      const int row = row0 + tok;
      seli[(size_t)row * NSEL + hh * TOPK + k] = (int)ti[(ab >> 4) * 128 + tok * 2] * PEER_KEYS + (int)ti[(ab & 15) * 128 + tok * 2 + 1];
      selg[(size_t)row * NSEL + hh * TOPK + k] = __expf(tv[tok * 16 + k] - mx) / den;
    }
  }
}

constexpr int PB_G = 4;
struct P6Blk { unsigned w[6]; unsigned sb; };
#ifdef EMU
#define READLANE_I(v, l) __shfl((int)(v), (l))
#define READLANE_F(v, l) __shfl((float)(v), (l))
#else
#define READLANE_I(v, l) __builtin_amdgcn_readlane((int)(v), (l))
#define READLANE_F(v, l) __builtin_bit_cast(float, __builtin_amdgcn_readlane(__builtin_bit_cast(int, (float)(v)), (l)))
#endif
__device__ __forceinline__ void ph_peer_apply(const Params& P, int layer, float* xlat, float* xctx_in, float* xctx_out, int nrows, bool write_next, char* smem, float* xlat_out = nullptr) {
  (void)smem;
  h16* xq = (h16*)(P.ws + O_ABUF);
  const unsigned char* tu = (const unsigned char*)(P.ws + O_TABU);
  const unsigned char* tv = (const unsigned char*)(P.ws + O_TABV);
  const int* seli = (const int*)(P.ws + O_SELI);
  const float* selg = (const float*)(P.ws + O_SELG);
  const float* g = P.ln_g + (size_t)(layer * 2 + 1) * D;
  const float* bb = P.ln_b + (size_t)(layer * 2 + 1) * D;
  const int tid = TIDX, wave = tid >> 6, lane = tid & 63;
  const bool lact = lane < P6_NB;
  const int lb = lact ? lane : 0;
  for (int row = blockIdx.x * (NTHR / 64) + wave; row < nrows; row += gridDim.x * (NTHR / 64)) {
    float xv[32];
#pragma unroll
    for (int j8 = 0; j8 < 4; ++j8) {
      const h16x8 t = *(const h16x8*)(xq + (size_t)row * D + lb * 32 + j8 * 8);
#pragma unroll
      for (int j = 0; j < 8; ++j) xv[j8 * 8 + j] = lact ? (float)t[j] : 0.f;
    }
    const int id0 = seli[(size_t)row * NSEL + lane], id1 = seli[(size_t)row * NSEL + 64 + lane];
    const float g0 = selg[(size_t)row * NSEL + lane], g1 = selg[(size_t)row * NSEL + 64 + lane];
    float a0 = 0.f, a1 = 0.f;
    P6Blk bufA[PB_G], bufB[PB_G];
#define PB_LOAD(buf, tab, grp) do { _Pragma("unroll") for (int k_ = 0; k_ < PB_G; ++k_) { const int e_ = (grp) * PB_G + k_; \
      const int id_ = READLANE_I(e_ < 64 ? id0 : id1, e_ & 63); const unsigned char* rp_ = (tab) + (size_t)id_ * P6_ROWB; \
      const unsigned* wp_ = (const unsigned*)(rp_ + lb * 24); \
      _Pragma("unroll") for (int q_ = 0; q_ < 6; ++q_) buf[k_].w[q_] = wp_[q_]; \
      buf[k_].sb = rp_[P6_NB * 24 + lb]; } } while (0)
#ifdef EMU
#define PB_FENCE
#else
#define PB_FENCE asm volatile("" ::: "memory")
#endif
#define PB_DOT(buf, grp) do { _Pragma("unroll") for (int k_ = 0; k_ < PB_G; ++k_) { const int e_ = (grp) * PB_G + k_; \
      float f_[32]; p6_decode32((u32x6){buf[k_].w[0], buf[k_].w[1], buf[k_].w[2], buf[k_].w[3], buf[k_].w[4], buf[k_].w[5]}, p6_scale_from_byte(buf[k_].sb), f_); \
      float acc_ = 0.f, acc2_ = 0.f; \
      _Pragma("unroll") for (int j_ = 0; j_ < 32; j_ += 2) { acc_ += xv[j_] * f_[j_]; acc2_ += xv[j_ + 1] * f_[j_ + 1]; } \
      acc_ = wave_sum(acc_ + acc2_); if (e_ < 64) { if (lane == e_) a0 = acc_; } else { if (lane == e_ - 64) a1 = acc_; } } } while (0)
    constexpr int NG = NSEL / PB_G;
    PB_LOAD(bufA, tu, 0);
    for (int gq = 0; gq < NG; gq += 2) {
      PB_LOAD(bufB, tu, gq + 1); PB_FENCE;
      PB_DOT(bufA, gq);
      if (gq + 2 < NG) PB_LOAD(bufA, tu, gq + 2);
      PB_FENCE;
      PB_DOT(bufB, gq + 1);
    }
    a0 = geluf_(a0) * g0; a1 = geluf_(a1) * g1;
    float o[32];
#pragma unroll
    for (int j = 0; j < 32; ++j) o[j] = 0.f;
#define PB_ACC(buf, grp) do { _Pragma("unroll") for (int k_ = 0; k_ < PB_G; ++k_) { const int e_ = (grp) * PB_G + k_; \
      const float a_ = READLANE_F(e_ < 64 ? a0 : a1, e_ & 63); \
      float f_[32]; p6_decode32((u32x6){buf[k_].w[0], buf[k_].w[1], buf[k_].w[2], buf[k_].w[3], buf[k_].w[4], buf[k_].w[5]}, p6_scale_from_byte(buf[k_].sb), f_); \
      _Pragma("unroll") for (int j_ = 0; j_ < 32; ++j_) o[j_] += a_ * f_[j_]; } } while (0)
    PB_LOAD(bufA, tv, 0);
    for (int gq = 0; gq < NG; gq += 2) {
      PB_LOAD(bufB, tv, gq + 1); PB_FENCE;
      PB_ACC(bufA, gq);
      if (gq + 2 < NG) PB_LOAD(bufA, tv, gq + 2);
      PB_FENCE;
      PB_ACC(bufB, gq + 1);
    }
#undef PB_LOAD
#undef PB_DOT
#undef PB_ACC
    const float* xs1 = (row < NL ? xlat + (size_t)row * D : xctx_in + (size_t)(row - NL) * D) + lb * 32;
    float* xo = (row < NL ? (xlat_out ? xlat_out : xlat) + (size_t)row * D : xctx_out + (size_t)(row - NL) * D) + lb * 32;
    const float* gt = mod_ptr(P, layer, row, 5) + lb * 32;
    float s = 0.f;
#pragma unroll
    for (int j4 = 0; j4 < 8; ++j4) {
      float4 xa; const float4 ga = *(const float4*)(gt + j4 * 4);
      if (row < NL) { const h16x4 xh_ = *(const h16x4*)((const h16*)(xlat + (size_t)row * D) + lb * 32 + j4 * 4); xa = make_float4((float)xh_[0], (float)xh_[1], (float)xh_[2], (float)xh_[3]); }
      else xa = *(const float4*)(xs1 + j4 * 4);
      o[j4 * 4 + 0] = ALPHA * xa.x + ga.x * o[j4 * 4 + 0]; o[j4 * 4 + 1] = ALPHA * xa.y + ga.y * o[j4 * 4 + 1];
      o[j4 * 4 + 2] = ALPHA * xa.z + ga.z * o[j4 * 4 + 2]; o[j4 * 4 + 3] = ALPHA * xa.w + ga.w * o[j4 * 4 + 3];
      s += (o[j4 * 4 + 0] + o[j4 * 4 + 1]) + (o[j4 * 4 + 2] + o[j4 * 4 + 3]);
    }
    s = wave_sum(lact ? s : 0.f);
    const float mu = s / (float)D;
    float s2 = 0.f;
#pragma unroll
    for (int j = 0; j < 32; ++j) { const float dd = o[j] - mu; s2 += dd * dd; }
    s2 = wave_sum(lact ? s2 : 0.f);
    const float rstd = rsqrtf(s2 / (float)D + LN_EPS);
    const float* gp = g + lb * 32; const float* bp = bb + lb * 32;
    const float* sh1n = mod_ptr(P, 1, row, 0) + lb * 32;
    const float* sc1n = mod_ptr(P, 1, row, 1) + lb * 32;
    if (lact) {
#pragma unroll
      for (int j4 = 0; j4 < 8; ++j4) {
        const float4 gv = *(const float4*)(gp + j4 * 4), bv = *(const float4*)(bp + j4 * 4);
        float4 ov;
        ov.x = (o[j4 * 4 + 0] - mu) * rstd * gv.x + bv.x; ov.y = (o[j4 * 4 + 1] - mu) * rstd * gv.y + bv.y;
        ov.z = (o[j4 * 4 + 2] - mu) * rstd * gv.z + bv.z; ov.w = (o[j4 * 4 + 3] - mu) * rstd * gv.w + bv.w;
        if (row < NL && write_next) { h16x4 oh_; oh_[0] = (h16)ov.x; oh_[1] = (h16)ov.y; oh_[2] = (h16)ov.z; oh_[3] = (h16)ov.w; *(h16x4*)((h16*)((xlat_out ? xlat_out : xlat) + (size_t)row * D) + lb * 32 + j4 * 4) = oh_; }
        else *(float4*)(xo + j4 * 4) = ov;
        if (write_next) {
          const float4 sv = *(const float4*)(sc1n + j4 * 4), hv = *(const float4*)(sh1n + j4 * 4);
          h16x4 nx;
          nx[0] = (h16)(ov.x * (1.f + sv.x) + hv.x); nx[1] = (h16)(ov.y * (1.f + sv.y) + hv.y);
          nx[2] = (h16)(ov.z * (1.f + sv.z) + hv.z); nx[3] = (h16)(ov.w * (1.f + sv.w) + hv.w);
          *(h16x4*)(xq + (size_t)row * D + lb * 32 + j4 * 4) = nx;
        }
      }
    }
  }
}

__device__ __forceinline__ void lru_chunk_info(int b, int n, int& rbase, int& L, int& t0) {
  if (n < LRU_LCH) { rbase = b * SEQ; L = SEQ; t0 = n * LRU_T; }
  else { rbase = NL + b * CTX_LEN; L = CTX_LEN; t0 = (n - LRU_LCH) * LRU_T; }
}
__device__ __forceinline__ int lru_order(int n, int dir) {
  if (n >= LRU_LCH) { int c = n - LRU_LCH; return dir == 0 ? c : LRU_CCH - 1 - c; }
  return LRU_CCH + (dir == 0 ? n : LRU_LCH - 1 - n);
}
__device__ __forceinline__ void lru_coeffs(const Params& P, int b, int n, int blk, float* xcs, float* as_, float* bs_, h16* xh) {
  const h16* pl = (const h16*)(P.ws + O_PLRU);
  const h16* lw = (const h16*)(P.ws + O_LW16);
  h16* cfa = (h16*)(P.ws + O_FEAT);
  h16* cfb = cfa + (size_t)2 * NL * LRUW;
  int rbase, L, t0; lru_chunk_info(b, n, rbase, L, t0);
  const int ch0 = blk * LRU_BD;
  const int tid = TIDX, wave = tid >> 6, lane = tid & 63;
  __syncthreads();
  {
    const int t = tid / 8, c8 = (tid % 8) * 8, chb = ch0 + c8;
    const float4 b0 = *(const float4*)(P.lru_conv_b + chb), b1 = *(const float4*)(P.lru_conv_b + chb + 4);
    float acc[8] = {b0.x, b0.y, b0.z, b0.w, b1.x, b1.y, b1.z, b1.w};
#pragma unroll
    for (int k = 0; k < 4; ++k) {
      const int tt = t0 + t + k - 1;
      if (tt >= 0 && tt < L) {
        const h16x8 pv = *(const h16x8*)(pl + (size_t)(rbase + tt) * (2 * LRUW) + chb);
        const float4 w0 = *(const float4*)(P.lru_conv_w + k * LRUW + chb), w1 = *(const float4*)(P.lru_conv_w + k * LRUW + chb + 4);
        acc[0] += w0.x * (float)pv[0]; acc[1] += w0.y * (float)pv[1]; acc[2] += w0.z * (float)pv[2]; acc[3] += w0.w * (float)pv[3];
        acc[4] += w1.x * (float)pv[4]; acc[5] += w1.y * (float)pv[5]; acc[6] += w1.z * (float)pv[6]; acc[7] += w1.w * (float)pv[7];
      }
    }
    h16x8 xv;
#pragma unroll
    for (int j = 0; j < 8; ++j) { xcs[t * 65 + c8 + j] = acc[j]; xv[j] = (h16)acc[j]; }
    *(h16x8*)(xh + t * 72 + c8) = xv;
  }
  __syncthreads();
  const int d = wave >> 2, nt = wave & 3;
  const int j = nt * 16 + (lane & 15), ch = ch0 + j;
  f32x4 accr[4], acci[4];
#pragma unroll
  for (int mt = 0; mt < 4; ++mt) { accr[mt] = (f32x4){0.f, 0.f, 0.f, 0.f}; acci[mt] = (f32x4){0.f, 0.f, 0.f, 0.f}; }
  const h16* wr = lw + (((size_t)(d * LRU_BLOCKS + blk) * 2 + 0) * 64 + j) * 64 + (lane >> 4) * 8;
  const h16* wi = wr + 64 * 64;
#pragma unroll
  for (int ks = 0; ks < 2; ++ks) {
    const h16x8 br = *(const h16x8*)(wr + ks * 32), bi = *(const h16x8*)(wi + ks * 32);
#pragma unroll
    for (int mt = 0; mt < 4; ++mt) {
      const h16x8 af = *(const h16x8*)(xh + (mt * 16 + (lane & 15)) * 72 + ks * 32 + (lane >> 4) * 8);
      accr[mt] = MFMA16(af, br, accr[mt]);
      acci[mt] = MFMA16(af, bi, acci[mt]);
    }
  }
  const float ba = P.lru_ba[d * LRUW + ch], bx = P.lru_bx[d * LRUW + ch];
  const float sp8 = -8.0f * softplusf_(-P.lru_lam[d * LRUW + ch]);
  const bool islat = n < LRU_LCH;
#pragma unroll
  for (int mt = 0; mt < 4; ++mt)
#pragma unroll
    for (int i = 0; i < 4; ++i) {
      const int t = mt * 16 + (lane >> 4) * 4 + i;
      const float r = 1.f / (1.f + __expf(-(accr[mt][i] + ba)));
      const float ig = 1.f / (1.f + __expf(-(acci[mt][i] + bx)));
      const float log_a = sp8 * r;
      const float a = __expf(log_a);
      const float bq = sqrtf(fmaxf(1.f - a * a, 0.f)) * (ig * xcs[t * 65 + j]);
      as_[(d * 64 + t) * 65 + j] = a;
      bs_[(d * 64 + t) * 65 + j] = bq;
      if (islat) {
        const size_t o = ((size_t)d * NL + rbase + t0 + t) * LRUW + ch;
        cfa[o] = (h16)log_a; cfb[o] = (h16)bq;
      }
    }
  __syncthreads();
}
__device__ __forceinline__ void ph_lru_a(const Params& P, char* smem) {
  float* xcs = (float*)smem; float* as_ = xcs + 64 * 65; float* bs_ = as_ + 2 * 64 * 65; h16* xh = (h16*)(bs_ + 2 * 64 * 65);
  float2* lsum = (float2*)(P.ws + O_LSUM);
  constexpr int NU = BATCH * LRU_NCH * LRU_BLOCKS;
  for (int u = blockIdx.x; u < NU; u += gridDim.x) {
    const int blk = u % LRU_BLOCKS, n = (u / LRU_BLOCKS) % LRU_NCH, b = u / (LRU_BLOCKS * LRU_NCH);
    lru_coeffs(P, b, n, blk, xcs, as_, bs_, xh);
    const int tid = TIDX;
    if (tid < 128) {
      const int d = tid / 64, j = tid % 64;
      float A = 1.f, Bv = 0.f;
      for (int s = 0; s < 64; ++s) {
        const int t = d == 0 ? s : 63 - s;
        const float a = as_[(d * 64 + t) * 65 + j];
        Bv = a * Bv + bs_[(d * 64 + t) * 65 + j];
        A *= a;
      }
      lsum[(((size_t)d * BATCH + b) * LRU_NCH + lru_order(n, d)) * LRUW + blk * 64 + j] = make_float2(A, Bv);
    }
  }
}
__device__ __forceinline__ void ph_lru_b(const Params& P) {
  const float2* lsum = (const float2*)(P.ws + O_LSUM);
  float* lcar = (float*)(P.ws + O_LCAR);
  const int total = 2 * BATCH * LRUW;
  static_assert(LRU_NCH % 4 == 0, "lru carry unroll");
  for (int i = blockIdx.x * NTHR + TIDX; i < total; i += gridDim.x * NTHR) {
    const int ch = i % LRUW, db = i / LRUW;
    float h = 0.f;
    for (int o = 0; o < LRU_NCH; o += 4) {
      const size_t off = ((size_t)db * LRU_NCH + o) * LRUW + ch;
      const float2 s0 = lsum[off], s1 = lsum[off + LRUW], s2 = lsum[off + 2 * LRUW], s3 = lsum[off + 3 * LRUW];
      lcar[off] = h; h = s0.x * h + s0.y;
      lcar[off + LRUW] = h; h = s1.x * h + s1.y;
      lcar[off + 2 * LRUW] = h; h = s2.x * h + s2.y;
      lcar[off + 3 * LRUW] = h; h = s3.x * h + s3.y;
    }
  }
}
__device__ __forceinline__ void ph_lru_c(const Params& P, char* smem) {
  float* as_ = (float*)smem; float* bs_ = as_ + 2 * 64 * 65;
  const float* lcar = (const float*)(P.ws + O_LCAR);
  const h16* pl = (const h16*)(P.ws + O_PLRU);
  const h16* cfa = (const h16*)(P.ws + O_FEAT);
  const h16* cfb = cfa + (size_t)2 * NL * LRUW;
  h16* mixl = (h16*)(P.ws + O_MIXLRU);
  constexpr int NU = BATCH * LRU_LCH * LRU_BLOCKS;
  for (int u = blockIdx.x; u < NU; u += gridDim.x) {
    const int blk = u % LRU_BLOCKS, n = (u / LRU_BLOCKS) % LRU_LCH, b = u / (LRU_BLOCKS * LRU_LCH);
    const int row0 = b * SEQ + n * LRU_T;
    const int tid = TIDX;
    __syncthreads();
#pragma unroll 4
    for (int i = tid; i < 2 * 64 * 16; i += NTHR) {
      const int c4 = i % 16, t = (i / 16) % 64, d = i / 1024;
      const size_t o = ((size_t)d * NL + row0 + t) * LRUW + blk * 64 + c4 * 4;
      const h16x4 la = *(const h16x4*)(cfa + o), bq = *(const h16x4*)(cfb + o);
#pragma unroll
      for (int q = 0; q < 4; ++q) { as_[(d * 64 + t) * 65 + c4 * 4 + q] = __expf((float)la[q]); bs_[(d * 64 + t) * 65 + c4 * 4 + q] = (float)bq[q]; }
    }
    __syncthreads();
    if (tid < 128) {
      const int d = tid / 64, j = tid % 64;
      float h = lcar[(((size_t)d * BATCH + b) * LRU_NCH + lru_order(n, d)) * LRUW + blk * 64 + j];
      for (int s = 0; s < 64; ++s) {
        const int t = d == 0 ? s : 63 - s;
        h = as_[(d * 64 + t) * 65 + j] * h + bs_[(d * 64 + t) * 65 + j];
        bs_[(d * 64 + t) * 65 + j] = h;
      }
    }
    __syncthreads();
#pragma unroll 2
    for (int i = tid; i < 64 * 16; i += NTHR) {
      const int t = i / 16, c4 = i % 16, ch = blk * 64 + c4 * 4;
      const h16x4 gate = *(const h16x4*)(pl + (size_t)(row0 + t) * (2 * LRUW) + LRUW + ch);
      h16x4 ov;
#pragma unroll
      for (int q = 0; q < 4; ++q) {
        const float y = bs_[(0 * 64 + t) * 65 + c4 * 4 + q] + bs_[(1 * 64 + t) * 65 + c4 * 4 + q];
        ov[q] = (h16)(y * geluf_((float)gate[q]));
      }
      *(h16x4*)(mixl + (size_t)(row0 + t) * LRUW + ch) = ov;
    }
  }
}

struct RwFeat { h16 *rec0, *sh, *v; h16* gls; float* bonus;
  __device__ __forceinline__ h16* rec(int d) const { return rec0 + (size_t)d * 3 * NT * RWW; } };
__device__ __forceinline__ RwFeat rw_feat(const Params& P) {
  RwFeat f;
  f.rec0 = (h16*)(P.ws + O_PLRU);
  f.v = f.rec0 + (size_t)6 * NT * RWW;
  f.sh = (h16*)(P.ws + O_ABUF);
  f.gls = (h16*)(P.ws + O_GLS); f.bonus = (float*)(P.ws + O_BONUS);
  return f;
}
static_assert(O_FEAT == O_PLRU + (size_t)NT * 2 * LRUW * 2 && LRUW == RWW, "rwkv records span P_lru + FEAT");
__device__ __forceinline__ void rw_shifted8(const Params& P, const h16* prw, int row, int col0, float* out) {
  int isc, b, t; row_decode(row, isc, b, t);
  const h16* pr = prw + (size_t)row * RW_SHIFT + col0;
  const h16x8 pv = *(const h16x8*)pr;
  const h16x8 z8 = (h16x8){0, 0, 0, 0, 0, 0, 0, 0};
  h16x8 n0 = z8, n1 = z8, n2 = z8, n3 = z8;
  if (!isc) {
    const int gr = t / GRID_W, gc = t % GRID_W;
    if (gc > 0) n0 = *(const h16x8*)(pr - RW_SHIFT);
    if (gc < GRID_W - 1) n1 = *(const h16x8*)(pr + RW_SHIFT);
    if (gr > 0) n2 = *(const h16x8*)(pr - (size_t)GRID_W * RW_SHIFT);
    if (gr < GRID_ROWS - 1) n3 = *(const h16x8*)(pr + (size_t)GRID_W * RW_SHIFT);
  } else {
    if (t > 0) n0 = *(const h16x8*)(pr - RW_SHIFT);
    if (t < CTX_LEN - 1) n1 = *(const h16x8*)(pr + RW_SHIFT);
    n2 = n0; n3 = n1;
  }
  const float4 m0 = *(const float4*)(P.rw_mu + col0), m1 = *(const float4*)(P.rw_mu + col0 + 4);
  const float mu[8] = {m0.x, m0.y, m0.z, m0.w, m1.x, m1.y, m1.z, m1.w};
#pragma unroll
  for (int j = 0; j < 8; ++j) {
    const float pvj = (float)pv[j];
    const float nb = (j & 3) == 0 ? (float)n0[j] : (j & 3) == 1 ? (float)n1[j] : (j & 3) == 2 ? (float)n2[j] : (float)n3[j];
    out[j] = pvj + (nb - pvj) * mu[j];
  }
}
__device__ __forceinline__ float sum8(float v) {
#ifdef EMU
  v += __shfl_xor(v, 1); v += __shfl_xor(v, 2); v += __shfl_xor(v, 4);
#else
  v += dppf<0xB1>(v); v += dppf<0x4E>(v); v += dppf<0x141>(v);
#endif
  return v;
}
__device__ __forceinline__ void ph_rw_feat(const Params& P, char* smem) {
  constexpr int LDK = RWW + 8;
  h16* lwh = (h16*)smem;
  h16* lah = lwh + 16 * 72;
  h16* ks = lah + 16 * 72;
  h16* kks = ks + 16 * LDK;
  h16* rs = kks + 16 * LDK;
  float* bon = (float*)(rs + 16 * LDK);
  const h16* prw = (const h16*)(P.ws + O_PRW);
  const h16* rw16 = (const h16*)(P.ws + O_RW16);
  RwFeat F = rw_feat(P);
  const int tid = TIDX, wave = tid >> 6, lane = tid & 63;
  for (int u = blockIdx.x; u < NT / 16; u += gridDim.x) {
    const int row0 = u * 16;
    __syncthreads();
    for (int i = tid; i < 16 * 16; i += NTHR) {
      const int tl = i / 16, g8 = i % 16;
      float v[8]; rw_shifted8(P, prw, row0 + tl, 3 * RWW + g8 * 8, v);
      h16x8 o;
      if (g8 < 8) {
#pragma unroll
        for (int j = 0; j < 8; ++j) o[j] = (h16)tanhf(v[j]);
        *(h16x8*)(lwh + tl * 72 + g8 * 8) = o;
      } else {
#pragma unroll
        for (int j = 0; j < 8; ++j) o[j] = (h16)v[j];
        *(h16x8*)(lah + tl * 72 + (g8 - 8) * 8) = o;
      }
    }
    for (int i = tid; i < 16 * 20; i += NTHR) {
      const int tl = i / 20, g8 = i % 20;
      float v[8]; rw_shifted8(P, prw, row0 + tl, 3 * RWW + 128 + g8 * 8, v);
      h16x8 o;
#pragma unroll
      for (int j = 0; j < 8; ++j) o[j] = (h16)v[j];
      *(h16x8*)(F.gls + (size_t)(row0 + tl) * 160 + g8 * 8) = o;
    }
    if (tid < 16 * RW_H) bon[tid] = 0.f;
#pragma unroll 2
    for (int it = tid; it < 16 * (RWW / 8); it += NTHR) {
      const int tl = it / (RWW / 8), j8 = (it % (RWW / 8)) * 8, row = row0 + tl;
      float r[8], kv[8], vv[8];
      rw_shifted8(P, prw, row, j8, r); rw_shifted8(P, prw, row, RWW + j8, kv); rw_shifted8(P, prw, row, 2 * RWW + j8, vv);
      const float4 k0 = *(const float4*)(P.rw_k_k + j8), k1 = *(const float4*)(P.rw_k_k + j8 + 4);
      const float kkw[8] = {k0.x, k0.y, k0.z, k0.w, k1.x, k1.y, k1.z, k1.w};
      float kr[8]; float n2 = 0.f;
#pragma unroll
      for (int j = 0; j < 8; ++j) { kr[j] = kv[j] * kkw[j]; n2 += kr[j] * kr[j]; }
      n2 = sum8(n2);
      const float rn = 1.f / fmaxf(sqrtf(n2), 1e-12f);
      h16x8 o_r, o_v, o_k, o_kk;
#pragma unroll
      for (int j = 0; j < 8; ++j) { o_r[j] = (h16)r[j]; o_v[j] = (h16)vv[j]; o_k[j] = (h16)kv[j]; o_kk[j] = (h16)(kr[j] * rn); }
      *(h16x8*)(F.v + (size_t)row * RWW + j8) = o_v;
      {
        h16* shp = F.sh + (size_t)row * RWW * 2 + (j8 / 4) * 8;
        h16x8 s0, s1;
#pragma unroll
        for (int j = 0; j < 4; ++j) { s0[j] = o_kk[j]; s0[4 + j] = o_r[j]; s1[j] = o_kk[4 + j]; s1[4 + j] = o_r[4 + j]; }
        *(h16x8*)shp = s0; *(h16x8*)(shp + 8) = s1;
      }
      *(h16x8*)(ks + tl * LDK + j8) = o_k; *(h16x8*)(kks + tl * LDK + j8) = o_kk; *(h16x8*)(rs + tl * LDK + j8) = o_r;
    }
    __syncthreads();
    h16x8 aw[2], aa[2];
#pragma unroll
    for (int kq = 0; kq < 2; ++kq) {
      aw[kq] = *(const h16x8*)(lwh + (lane & 15) * 72 + kq * 32 + (lane >> 4) * 8);
      aa[kq] = *(const h16x8*)(lah + (lane & 15) * 72 + kq * 32 + (lane >> 4) * 8);
    }
    for (int it = wave; it < 2 * (RWW / 16); it += NTHR / 64) {
      const int d = it / (RWW / 16), nt = it % (RWW / 16);
      const int n = nt * 16 + (lane & 15);
      const h16* bw = rw16 + (((size_t)(d * 2 + 0) * RWW + n) * 64) + (lane >> 4) * 8;
      const h16* ba = rw16 + (((size_t)(d * 2 + 1) * RWW + n) * 64) + (lane >> 4) * 8;
      f32x4 cw = (f32x4){0.f, 0.f, 0.f, 0.f}, ca = (f32x4){0.f, 0.f, 0.f, 0.f};
#pragma unroll
      for (int kq = 0; kq < 2; ++kq) {
        cw = MFMA16(aw[kq], *(const h16x8*)(bw + kq * 32), cw);
        ca = MFMA16(aa[kq], *(const h16x8*)(ba + kq * 32), ca);
      }
      const float w0 = P.rw_w0[d * RWW + n], a0 = P.rw_a0[d * RWW + n], ka = P.rw_k_a[n], rk = P.rw_r_k[n];
      h16* prec = F.rec(d) + (n / 4) * 12 + (n % 4);
#pragma unroll
      for (int i = 0; i < 4; ++i) {
        const int tl = (lane >> 4) * 4 + i, row = row0 + tl;
        const float xw = -(w0 + cw[i]);
        const float spl = xw > 20.f ? xw : __logf(1.f + __expf(xw));
        const float wn = __expf(-spl - 0.5f);
        const float om = wn < 0.01f ? wn * (1.f - 0.5f * wn * (1.f - wn * 0.33333334f)) : 1.f - __expf(-wn);
        const float a = 1.f / (1.f + __expf(-(a0 + ca[i])));
        const float kv = (float)ks[tl * LDK + n], kk = (float)kks[tl * LDK + n], r = (float)rs[tl * LDK + n];
        const float kd = kv * (1.f + (a - 1.f) * ka);
        prec[(size_t)row * RWW * 3] = (h16)(-om);
        prec[(size_t)row * RWW * 3 + 4] = (h16)kd;
        prec[(size_t)row * RWW * 3 + 8] = (h16)(-(kk * a));
        const float bsum = row_sum16(r * kd * rk);
        if ((lane & 15) == 0) atomicAdd(&bon[tl * RW_H + n / 64], bsum);
      }
    }
    __syncthreads();
    if (tid < 16 * RW_H) F.bonus[(size_t)(row0 + tid / RW_H) * RW_H + tid % RW_H] = bon[tid];
  }
}
static_assert(NT % 16 == 0, "rw feat units");

#ifdef EMU
__device__ __forceinline__ float fmix_lo(float a, unsigned pk, float c) { h16x2 h = __builtin_bit_cast(h16x2, pk); return a * (float)h[0] + c; }
__device__ __forceinline__ float fmix_hi(float a, unsigned pk, float c) { h16x2 h = __builtin_bit_cast(h16x2, pk); return a * (float)h[1] + c; }
#else
__device__ __forceinline__ float fmix_lo(float a, unsigned pk, float c) {
  float r; asm("v_fma_mix_f32 %0, %1, %2, %3 op_sel_hi:[0,1,0]" : "=v"(r) : "v"(a), "v"(pk), "v"(c)); return r; }
__device__ __forceinline__ float fmix_hi(float a, unsigned pk, float c) {
  float r; asm("v_fma_mix_f32 %0, %1, %2, %3 op_sel:[0,1,0] op_sel_hi:[0,1,0]" : "=v"(r) : "v"(a), "v"(pk), "v"(c)); return r; }
#endif
constexpr int RW_U = 8;
constexpr int RW_NS = CTX_LEN + SEQ;
static_assert(CTX_LEN % RW_U == 0 && SEQ % RW_U == 0, "scan blocks");
template <int VAR>
__device__ __forceinline__ void ph_rw_scan(const Params& P) {
  RwFeat F = rw_feat(P);
  h16* yout = (h16*)(P.ws + O_PRW);
#ifdef EMU
  const int tid = TIDX, wave = tid / 64, lane = tid % 64;
#else
  const int tid = TIDX, wave = __builtin_amdgcn_readfirstlane(tid / 64), lane = tid % 64;
#endif
  const int rl = lane / 16, q = lane % 16;
  constexpr int NWU = 2 * BATCH * RW_H * 16;
  for (int wu = blockIdx.x * 4 + wave; wave < 4 && wu < NWU; wu += gridDim.x * 4) {
    const int rg = wu % 16, hh = (wu / 16) % RW_H, b = (wu / (16 * RW_H)) % BATCH, dir = wu / (16 * RW_H * BATCH);
    const int vrow = rg * 4 + rl;
    const h16* p_rec = F.rec(dir); const h16* p_sh = F.sh; const h16* p_v = F.v;
    const unsigned g_ = (unsigned)(hh * 16 + q);
    const unsigned uvoff = (unsigned)(hh * 64 + vrow), urec = g_ * 12u, ush = g_ * 8u;
    h16x8 s_ok[RW_U], s_kr[RW_U]; h16x4 s_b[RW_U]; h16 s_v[RW_U];
    auto row_of = [&](int step) -> int {
      if (step < CTX_LEN) return NL + b * CTX_LEN + (dir == 0 ? step : CTX_LEN - 1 - step);
      const int s = step - CTX_LEN; return b * SEQ + (dir == 0 ? s : SEQ - 1 - s);
    };
#define RW_LOAD(slot, step) do { const size_t ro_ = (size_t)row_of(step) * RWW; \
      s_ok[slot] = *(const h16x8*)((p_rec + ro_ * 3) + urec); s_b[slot] = *(const h16x4*)((p_rec + ro_ * 3) + urec + 8); \
      s_kr[slot] = *(const h16x8*)((p_sh + ro_ * 2) + ush); s_v[slot] = (p_v + ro_)[uvoff]; } while (0)
#pragma unroll
    for (int uu = 0; uu < RW_U; ++uu) RW_LOAD(uu, uu);
    float S[4] = {0.f, 0.f, 0.f, 0.f};
    for (int t0 = 0; t0 < RW_NS; t0 += RW_U) {
      const bool islat = t0 >= CTX_LEN;
#pragma unroll
      for (int uu = 0; uu < RW_U; ++uu) {
        const float vv = (float)s_v[uu];
        const u32x4 p_ok = __builtin_bit_cast(u32x4, s_ok[uu]), p_kr = __builtin_bit_cast(u32x4, s_kr[uu]);
        const u32x2 p_bb = __builtin_bit_cast(u32x2, s_b[uu]);
        const unsigned om0 = p_ok[0], om1 = p_ok[1], kd0 = p_ok[2], kd1 = p_ok[3];
        const unsigned kk0 = p_kr[0], kk1 = p_kr[1], r0_ = p_kr[2], r1_ = p_kr[3];
        const unsigned b0_ = p_bb[0], b1_ = p_bb[1];
        float sa = fmix_lo(S[0], kk0, 0.f); sa = fmix_hi(S[1], kk0, sa);
        float sb = fmix_lo(S[2], kk1, 0.f); sb = fmix_hi(S[3], kk1, sb);
        sa = row_sum16(sa + sb);
        S[0] = fmix_lo(S[0], om0, S[0]); S[1] = fmix_hi(S[1], om0, S[1]); S[2] = fmix_lo(S[2], om1, S[2]); S[3] = fmix_hi(S[3], om1, S[3]);
        S[0] = fmix_lo(sa, b0_, S[0]); S[1] = fmix_hi(sa, b0_, S[1]); S[2] = fmix_lo(sa, b1_, S[2]); S[3] = fmix_hi(sa, b1_, S[3]);
        S[0] = fmix_lo(vv, kd0, S[0]); S[1] = fmix_hi(vv, kd0, S[1]); S[2] = fmix_lo(vv, kd1, S[2]); S[3] = fmix_hi(vv, kd1, S[3]);
        float y = fmix_lo(S[0], r0_, 0.f); y = fmix_hi(S[1], r0_, y);
        float y2 = fmix_lo(S[2], r1_, 0.f); y2 = fmix_hi(S[3], r1_, y2);
        y += y2;
        if (VAR == 0 && islat) {
          y = row_sum16(y);
          if (q == 0) yout[((size_t)dir * NL + row_of(t0 + uu)) * RWW + hh * 64 + vrow] = (h16)y;
        }
        if (VAR != 0) asm volatile("" :: "v"(y));
        const int nstep = t0 + uu + RW_U < RW_NS ? t0 + uu + RW_U : RW_NS - 1;
        if (VAR != 2) RW_LOAD(uu, nstep);
      }
    }
    if (VAR != 0) asm volatile("" :: "v"(S[0]), "v"(S[1]), "v"(S[2]), "v"(S[3]));
#undef RW_LOAD
  }
}

__device__ __forceinline__ void ph_rw_out(const Params& P, char* smem) {
  constexpr int LDG = 168;
  h16* sg = (h16*)smem;
  float* ys = (float*)(sg + 16 * LDG);
  float* st = ys + 16 * (RWW + 4);
  constexpr int LDY = RWW + 4;
  RwFeat F = rw_feat(P);
  const h16* g2t = (const h16*)(P.ws + O_G216);
  h16* yf = (h16*)(P.ws + O_PRW);
  h16* yb = yf + (size_t)NL * RWW;
  const int tid = TIDX, wave = tid >> 6, lane = tid & 63;
  for (int u = blockIdx.x; u < NL / 16; u += gridDim.x) {
    const int row0 = u * 16;
    __syncthreads();
    for (int i = tid; i < 16 * 20; i += NTHR) {
      const int tl = i / 20, g8 = i % 20;
      const h16x8 v = *(const h16x8*)(F.gls + (size_t)(row0 + tl) * 160 + g8 * 8);
      h16x8 o;
#pragma unroll
      for (int j = 0; j < 8; ++j) o[j] = (h16)(1.f / (1.f + __expf(-(float)v[j])));
      *(h16x8*)(sg + tl * LDG + g8 * 8) = o;
    }
    for (int it = tid; it < 16 * (RWW / 8); it += NTHR) {
      const int tl = it / (RWW / 8), j8 = (it % (RWW / 8)) * 8;
      const size_t o = (size_t)(row0 + tl) * RWW + j8;
      const h16x8 a = *(const h16x8*)(yf + o), b = *(const h16x8*)(yb + o);
      float y[8]; float s = 0.f;
#pragma unroll
      for (int j = 0; j < 8; ++j) { y[j] = (float)a[j] + (float)b[j]; s += y[j]; ys[tl * LDY + j8 + j] = y[j]; }
      s = sum8(s);
      const float mu = s * (1.f / 64.f);
      float s2 = 0.f;
#pragma unroll
      for (int j = 0; j < 8; ++j) { const float d_ = y[j] - mu; s2 += d_ * d_; }
      s2 = sum8(s2);
      if ((it & 7) == 0) { const int hh = j8 / 64; st[(tl * RW_H + hh) * 2] = mu; st[(tl * RW_H + hh) * 2 + 1] = rsqrtf(s2 * (1.f / 64.f) + RW_EPS); }
    }
    __syncthreads();
    h16x8 af[5];
#pragma unroll
    for (int ks = 0; ks < 5; ++ks) af[ks] = *(const h16x8*)(sg + (lane & 15) * LDG + ks * 32 + (lane >> 4) * 8);
    for (int nt = wave; nt < RWW / 16; nt += NTHR / 64) {
      const int n = nt * 16 + (lane & 15);
      f32x4 acc = (f32x4){0.f, 0.f, 0.f, 0.f};
#pragma unroll
      for (int ks = 0; ks < 5; ++ks) acc = MFMA16(af[ks], *(const h16x8*)(g2t + (size_t)n * 160 + ks * 32 + (lane >> 4) * 8), acc);
      const int hh = n / 64;
      const float gg = P.rw_gn_g[n], gb = P.rw_gn_b[n];
#pragma unroll
      for (int i = 0; i < 4; ++i) {
        const int tl = (lane >> 4) * 4 + i, row = row0 + tl;
        const float yn = (ys[tl * LDY + n] - st[(tl * RW_H + hh) * 2]) * st[(tl * RW_H + hh) * 2 + 1] * gg + gb;
        const float bon = F.bonus[(size_t)row * RW_H + hh] * (float)F.v[(size_t)row * RWW + n];
        yf[(size_t)row * RWW + n] = (h16)((yn + bon) * acc[i]);
      }
    }
  }
}

#ifdef EMU
static int emu_stop_at = -1;
#define PHASE_END(k) do { GRID_SYNC(); if (emu_stop_at == (k)) return; } while (0)
#else
#define PHASE_END(k) GRID_SYNC()
#endif
#ifndef REP_MASK
#define REP_MASK 0u
#endif
#define REP(k, ...) do { __VA_ARGS__; if (REP_MASK & (1u << (k))) { GRID_SYNC(); __VA_ARGS__; } } while (0)
__global__ void __launch_bounds__(NTHR, 2) mega_kernel(Params Pk) {
  DECL_SMEM;
#ifdef EMU
  #define PH(...) { const Params& P = Pk; __VA_ARGS__; }
#else
  typedef const __attribute__((address_space(4))) Params* KArg;
  #define XCP(f) P.f = q_->f;
  #define PH(...) { KArg q_ = (KArg)__builtin_amdgcn_kernarg_segment_ptr(); asm volatile("" : "+s"(q_)); Params P; \
                    PARAM_FIELDS(XCP) P.out = q_->out; P.ws = q_->ws; char* ws = P.ws; (void)ws; __VA_ARGS__; }
#endif
#ifndef EMU
  if (TIDX == 0) *(uint4*)(smem + 131072 + 512) = make_uint4(0u, 0u, 0u, 0u);
  __syncthreads();
  XcdBarrier gbar = xcd_barrier_post((unsigned*)(Pk.ws + O_BAR), (volatile LAS unsigned*)(smem + 131072 + 512));
#endif
#ifdef EMU
  char* ws = Pk.ws;
#endif
  #define xc1 ((float*)(ws + O_XC1))
  #define xc2 ((float*)(ws + O_XC2))
  REP(0, PH(ph_prologue(P, smem)));
  PHASE_END(0);
  REP(0, PH(ph_modulate0(P)));
  PHASE_END(1);
  REP(1, PH(gemm_phase<false, D, D, 0>((const h16*)(ws + O_ABUF), (const h16*)(ws + O_ABUF), (const h16*)(ws + O_WIN), NT, NP_EV, smem,
             EpiStoreH16{(h16*)(ws + O_P0), NP_EV, NP_EV})));
  REP(15, PH(ph_filter(P, smem)));
  PHASE_END(2);
  REP(16, PH(ph_hyena_pre(P, smem)));
  PH(ph_rope(P));
  PHASE_END(3);
  PH(ph_hyena_fft(P, smem));
  if (REP_MASK & (1u << 21)) { GRID_SYNC(); PH(ph_hyena_pre(P, smem)); GRID_SYNC(); PH(ph_hyena_fft(P, smem)); }
  PHASE_END(4);
  REP(17, PH(ph_hyena_post(P, smem)));
  PHASE_END(5);
  REP(3, PH(ph_ret_inter(P, smem)));
  PHASE_END(6);
  REP(4, PH(ph_ret_out(P, smem)));
  PHASE_END(7);
  REP(5, PH(gemm_phase<false, D, D, 0>((const h16*)(ws + O_ABUF), (const h16*)(ws + O_ABUF), (const h16*)(ws + O_WOUT), NT, D, smem,
             EpiStoreH16{(h16*)(ws + O_P0), D, D})));
  PHASE_END(8);
  REP(14, PH(ph_ln1<false, true>(P, 0, P.x, P.ctx, P.out, xc1, (const h16*)(ws + O_P0), NT, smem)));
  PHASE_END(9);
  REP(5, PH(gemm_phase<false, D, D, 0>((const h16*)(ws + O_ABUF), (const h16*)(ws + O_ABUF), (const h16*)(ws + O_WQ), NT, QW, smem,
             EpiStoreH16{(h16*)(ws + O_P0), QW, QW})));
  PHASE_END(10);
  REP(6, PH(ph_peer_select(P, 0, (const h16*)(ws + O_P0), NT, smem)));
  PHASE_END(11);
  if (REP_MASK & (1u << 23)) { PH(ph_peer_apply(P, 0, P.out, xc1, (float*)(ws + O_FFTS), NT, false, smem, (float*)(ws + O_P0))); GRID_SYNC(); }
  PH(ph_peer_apply(P, 0, P.out, xc1, xc2, NT, true, smem));
  PHASE_END(12);
  REP(7, PH(convert_layer_weights(P, 1, smem)));
  PHASE_END(13);
  REP(8, PH(gemm_phase<false, D, D, 0>((const h16*)(ws + O_ABUF), (const h16*)(ws + O_ABUF), (const h16*)(ws + O_WIN), NT, NP_OD, smem,
             EpiOddIn{(h16*)(ws + O_PRW), (h16*)(ws + O_PLRU)})));
  PHASE_END(14);
  REP(18, PH(ph_lru_a(P, smem)));
  PHASE_END(15);
  REP(19, PH(ph_lru_b(P)));
  PHASE_END(16);
  REP(20, PH(ph_lru_c(P, smem)));
  PHASE_END(17);
  REP(10, PH(ph_rw_feat(P, smem)));
  PHASE_END(18);
  if (REP_MASK & (1u << 24)) { PH(ph_rw_scan<1>(P)); GRID_SYNC(); }
  if (REP_MASK & (1u << 25)) { PH(ph_rw_scan<2>(P)); GRID_SYNC(); }
  REP(11, PH(ph_rw_scan<0>(P)));
  PHASE_END(19);
  PH(ph_rw_out(P, smem));
  if (REP_MASK & (1u << 22)) { GRID_SYNC(); PH(ph_rw_scan<0>(P)); GRID_SYNC(); PH(ph_rw_out(P, smem)); }
  PHASE_END(20);
  REP(13, PH(gemm_phase<true, RWW, LRUW, RWW / 64>((const h16*)(ws + O_PRW), (const h16*)(ws + O_MIXLRU), (const h16*)(ws + O_WOUT), NL, D, smem,
             EpiStoreH16{(h16*)(ws + O_FEAT), D, D})));
  PHASE_END(21);
  PH(ph_ln1<true, true>(P, 1, P.out, xc2, P.out, xc2, (const h16*)(ws + O_FEAT), NL, smem));
  PHASE_END(22);
  REP(13, PH(gemm_phase<false, D, D, 0>((const h16*)(ws + O_ABUF), (const h16*)(ws + O_ABUF), (const h16*)(ws + O_WQ), NL, QW, smem,
             EpiStoreH16{(h16*)(ws + O_FEAT), QW, QW})));
  PHASE_END(23);
  REP(6, PH(ph_peer_select(P, 1, (const h16*)(ws + O_FEAT), NL, smem)));
  PHASE_END(24);
  if (REP_MASK & (1u << 23)) { PH(ph_peer_apply(P, 1, P.out, xc2, xc2, NL, false, smem, (float*)(ws + O_FEAT))); GRID_SYNC(); }
  PH(ph_peer_apply(P, 1, P.out, xc2, xc2, NL, false, smem));
}

extern "C" void kernel_launch(void* const* d_in, const int* in_sizes, int n_in,
                              void* d_out, int out_size, void* d_ws, size_t ws_size,
                              hipStream_t stream) {
  (void)in_sizes; (void)out_size; (void)ws_size;
  Params p{};
  const float** fp = (const float**)&p;
  for (int i = 0; i < 46 && i < n_in; ++i) fp[i] = (const float*)d_in[i];
  p.out = (float*)d_out;
  p.ws = (char*)d_ws;
#ifdef EMU
  memset(d_ws, 0, 16384);
  emu_launch(dim3(MAXGRID), dim3(NTHR), LDS_BYTES, [=]() { mega_kernel(p); });
#else
  static int grid = 0;
  if (!grid) {
    int dev = 0, cus = 0, per_cu = 0;
    hipGetDevice(&dev);
    hipDeviceGetAttribute(&cus, hipDeviceAttributeMultiprocessorCount, dev);
    hipFuncSetAttribute((const void*)mega_kernel, hipFuncAttributeMaxDynamicSharedMemorySize, (int)LDS_BYTES);
    hipOccupancyMaxActiveBlocksPerMultiprocessor(&per_cu, mega_kernel, NTHR, LDS_BYTES);
    if (per_cu < 1) per_cu = 1;
    grid = cus * 1;
    if (grid > MAXGRID) grid = MAXGRID;
  }
  hipMemsetAsync(d_ws, 0, 16384, stream);
  mega_kernel<<<dim3(grid), dim3(NTHR), LDS_BYTES, stream>>>(p);
#endif
}
```
